# Optimizing an MI355X kernel written in HIP

```python
import jax, jax.numpy as jnp
from jax import lax
import numpy as np

D_MODEL = 1024
BATCH = 8
SEQ = 4096
DEPTH = 1

PLE_DIM = 256
MLA_HEADS = 8
QK_NOPE_DIM = 64
QK_ROPE_DIM = 32
V_HEAD_DIM = 64
Q_LORA_RANK = 384
KV_LORA_RANK = 256
ROPE_THETA = 10000.0
Q_BLOCK = 128
CONV_CHANNELS = 512
CONV_WIDTH = 31
MLA_WIDTH = MLA_HEADS * V_HEAD_DIM
D_MIX = MLA_WIDTH + CONV_CHANNELS
IN_PROJ_DIM = Q_LORA_RANK + KV_LORA_RANK + QK_ROPE_DIM + 2 * CONV_CHANNELS
D_FF = 2816
FFN_CONV_WIDTH = 3
NORM_EPS = 1e-6

kernel_name = "hymba_mla_conformer_convffn_sandwich_ple"


def rms_norm(x, g):
    xf = x.astype(jnp.float32)
    y = xf * lax.rsqrt(jnp.mean(xf * xf, axis=-1, keepdims=True) + NORM_EPS)
    return (y * g.astype(jnp.float32)).astype(x.dtype)


def layer_norm(x, g, b):
    xf = x.astype(jnp.float32)
    mu = jnp.mean(xf, axis=-1, keepdims=True)
    xc = xf - mu
    y = xc * lax.rsqrt(jnp.mean(xc * xc, axis=-1, keepdims=True) + NORM_EPS)
    return (y * g.astype(jnp.float32) + b.astype(jnp.float32)).astype(x.dtype)


def causal_depthwise_conv(x, w, b):
    k = w.shape[0]
    out = lax.conv_general_dilated(
        x, w[:, None, :].astype(x.dtype), window_strides=(1,), padding=((k - 1, 0),),
        dimension_numbers=('NWC', 'WIO', 'NWC'), feature_group_count=x.shape[-1])
    return out + b.astype(x.dtype)


def apply_rope(x, cos, sin):
    x1, x2 = jnp.split(x, 2, axis=-1)
    return jnp.concatenate([x1 * cos - x2 * sin, x1 * sin + x2 * cos], axis=-1)


def causal_mla_attention(q_nope, q_rope, k_nope, k_rope, v):
    b, s, h, _ = q_nope.shape
    nb = s // Q_BLOCK
    scale = (QK_NOPE_DIM + QK_ROPE_DIM) ** -0.5
    k_idx = jnp.arange(s)

    def to_blocks(t):
        return jnp.moveaxis(t.reshape(b, nb, Q_BLOCK, *t.shape[2:]), 1, 0)

    def block(args):
        qn, qr, start = args
        sc = (jnp.einsum('bqhd,bkhd->bhqk', qn, k_nope, preferred_element_type=jnp.float32)
              + jnp.einsum('bqhr,bkr->bhqk', qr, k_rope, preferred_element_type=jnp.float32)) * scale
        q_idx = start + jnp.arange(Q_BLOCK)
        sc = jnp.where(k_idx[None, :] <= q_idx[:, None], sc, -jnp.inf)
        pr = jax.nn.softmax(sc, axis=-1).astype(v.dtype)
        return jnp.einsum('bhqk,bkhd->bqhd', pr, v)

    starts = jnp.arange(nb) * Q_BLOCK
    out = lax.map(block, (to_blocks(q_nope), to_blocks(q_rope), starts))
    return jnp.moveaxis(out, 0, 1).reshape(b, s, h * V_HEAD_DIM)


def hybrid_mixer(xn, cos, sin, w_in, g_q_a, w_q_b, g_kv_a, w_kv_b,
                 conv_w, conv_b, conv_ln_g, conv_ln_b, w_o):
    b, s, _ = xn.shape
    proj = xn @ w_in
    o1 = Q_LORA_RANK
    o2 = o1 + KV_LORA_RANK
    o3 = o2 + QK_ROPE_DIM
    q_a, kv_a, k_rope, conv_in = jnp.split(proj, [o1, o2, o3], axis=-1)
    q = (rms_norm(q_a, g_q_a) @ w_q_b).reshape(b, s, MLA_HEADS, QK_NOPE_DIM + QK_ROPE_DIM)
    q_nope, q_rope = jnp.split(q, [QK_NOPE_DIM], axis=-1)
    kv = (rms_norm(kv_a, g_kv_a) @ w_kv_b).reshape(b, s, MLA_HEADS, QK_NOPE_DIM + V_HEAD_DIM)
    k_nope, v = jnp.split(kv, [QK_NOPE_DIM], axis=-1)
    q_rope = apply_rope(q_rope, cos[:, :, None, :], sin[:, :, None, :])
    k_rope = apply_rope(k_rope, cos, sin)
    attn = causal_mla_attention(q_nope, q_rope, k_nope, k_rope, v)
    a, gate = jnp.split(conv_in, 2, axis=-1)
    c = a * jax.nn.sigmoid(gate)
    c = causal_depthwise_conv(c, conv_w, conv_b)
    c = jax.nn.silu(layer_norm(c, conv_ln_g, conv_ln_b))
    return jnp.concatenate([attn, c], axis=-1) @ w_o


def conv_gated_ffn(xn, w_gate, w_up, dw_w, dw_b, w_down):
    g = causal_depthwise_conv(xn @ w_gate, dw_w, dw_b)
    return (jax.nn.gelu(g, approximate=True) * (xn @ w_up)) @ w_down


def setup_inputs(seed: int = 0) -> dict:
    key = jax.random.key(seed)
    ks = iter(jax.random.split(key, 40))

    def w(shape, fan_in):
        return jax.random.normal(next(ks), shape, jnp.float32) * fan_in ** -0.5

    def gain(shape):
        return 1.0 + 0.05 * jax.random.normal(next(ks), shape, jnp.float32)

    def bias(shape):
        return 0.01 * jax.random.normal(next(ks), shape, jnp.float32)

    L = DEPTH
    x = jax.random.normal(next(ks), (BATCH, SEQ, D_MODEL), jnp.float32)
    p = jax.random.normal(next(ks), (DEPTH, BATCH, SEQ, PLE_DIM), jnp.float32)
    positions = jnp.broadcast_to(jnp.arange(SEQ, dtype=jnp.int32)[None, :], (BATCH, SEQ))
    return {
        "x": x,
        "p": p,
        "positions": positions,
        "g_mix_pre": gain((L, D_MODEL)),
        "w_in": w((L, D_MODEL, IN_PROJ_DIM), D_MODEL),
        "g_q_a": gain((L, Q_LORA_RANK)),
        "w_q_b": w((L, Q_LORA_RANK, MLA_HEADS * (QK_NOPE_DIM + QK_ROPE_DIM)), Q_LORA_RANK),
        "g_kv_a": gain((L, KV_LORA_RANK)),
        "w_kv_b": w((L, KV_LORA_RANK, MLA_HEADS * (QK_NOPE_DIM + V_HEAD_DIM)), KV_LORA_RANK),
        "conv_w": w((L, CONV_WIDTH, CONV_CHANNELS), CONV_WIDTH),
        "conv_b": bias((L, CONV_CHANNELS)),
        "conv_ln_g": gain((L, CONV_CHANNELS)),
        "conv_ln_b": bias((L, CONV_CHANNELS)),
        "w_o": w((L, D_MIX, D_MODEL), D_MIX),
        "g_mix_post": gain((L, D_MODEL)),
        "g_ffn_pre": gain((L, D_MODEL)),
        "w_ffn_gate": w((L, D_MODEL, D_FF), D_MODEL),
        "w_ffn_up": w((L, D_MODEL, D_FF), D_MODEL),
        "ffn_dw_w": w((L, FFN_CONV_WIDTH, D_FF), FFN_CONV_WIDTH),
        "ffn_dw_b": bias((L, D_FF)),
        "w_ffn_down": w((L, D_FF, D_MODEL), D_FF),
        "g_ffn_post": gain((L, D_MODEL)),
        "w_ple_proj": w((L, PLE_DIM, D_MODEL), PLE_DIM),
        "g_ple": gain((L, D_MODEL)),
        "w_ple_gate": w((L, D_MODEL, D_MODEL), D_MODEL),
    }


def reference(x, p, positions, g_mix_pre, w_in, g_q_a, w_q_b, g_kv_a, w_kv_b,
              conv_w, conv_b, conv_ln_g, conv_ln_b, w_o, g_mix_post, g_ffn_pre,
              w_ffn_gate, w_ffn_up, ffn_dw_w, ffn_dw_b, w_ffn_down, g_ffn_post,
              w_ple_proj, g_ple, w_ple_gate):
    inv_freq = ROPE_THETA ** (-jnp.arange(0, QK_ROPE_DIM, 2, dtype=jnp.float32) / QK_ROPE_DIM)
    ang = positions.astype(jnp.float32)[..., None] * inv_freq
    cos = jnp.cos(ang).astype(x.dtype)
    sin = jnp.sin(ang).astype(x.dtype)

    h = x
    for i in range(DEPTH):
        mix = hybrid_mixer(rms_norm(h, g_mix_pre[i]), cos, sin, w_in[i], g_q_a[i], w_q_b[i],
                           g_kv_a[i], w_kv_b[i], conv_w[i], conv_b[i], conv_ln_g[i],
                           conv_ln_b[i], w_o[i])
        h = h + rms_norm(mix, g_mix_post[i])
        ffn = conv_gated_ffn(rms_norm(h, g_ffn_pre[i]), w_ffn_gate[i], w_ffn_up[i],
                             ffn_dw_w[i], ffn_dw_b[i], w_ffn_down[i])
        h = h + rms_norm(ffn, g_ffn_post[i])
        e = rms_norm(p[i] @ w_ple_proj[i], g_ple[i])
        h = h + jax.nn.sigmoid(h @ w_ple_gate[i]) * e
    return h
```

```cpp
#include <hip/hip_runtime.h>
#include <hip/hip_cooperative_groups.h>
#include <cstdio>
#include <cstdint>
#include <cmath>
namespace cg = cooperative_groups;
namespace pg8 {
#define PG8_LAS __attribute__((address_space(3)))
typedef unsigned short bf16_t;
typedef short bf16x8 __attribute__((ext_vector_type(8)));
typedef float f32x4 __attribute__((ext_vector_type(4)));
typedef unsigned u32x4 __attribute__((ext_vector_type(4)));
constexpr int BM = 256, BK = 64, HALF = 128, HTB = HALF * BK * 2  , STAGE_BYTES = 8 * HTB, NXCD = 8, WGM = 8;

__host__ __device__ __forceinline__ int lds_byte(int r, int c) { const int st = (r >> 4) * 2 + (c >> 5), rr = r & 15, cc = c & 31, ob = rr * 64 + cc * 2; return st * 1024 + (ob ^ (((ob >> 9) & 1) << 5)); }
__host__ __device__ __forceinline__ void stage_rc(int b, int& R, int& C) { const int st = b / 1024, sb = b % 1024, swz = sb ^ (((sb >> 9) & 1) << 5); R = (st >> 1) * 16 + swz / 64; C = (st & 1) * 32 + (swz % 64) / 2; }
__host__ __device__ __forceinline__ int perm32(int rho) { const int n = rho >> 4, i = rho & 15; return 8 * (i >> 2) + 4 * n + (i & 3); }

struct Unit { int pm, pn; };
struct Gemm { const bf16_t* A; const bf16_t* Bt; int M, N, K; };

struct StaticOrder {
    int nM, nN, nwg, G, c;
    __host__ __device__ void init(int M, int N, int G_, int c_) { nM = M / BM; nN = N / BM; nwg = nM * nN; G = G_; c = c_; }
    __host__ __device__ bool next(int i, Unit& u) const {
        const int L = i * G + c; if (L >= nwg) return false;
        int wgid = L; { const int q = nwg / NXCD, r = nwg % NXCD, xcd = wgid % NXCD, off = wgid / NXCD; wgid = (xcd < r ? xcd * (q + 1) : r * (q + 1) + (xcd - r) * q) + off; }
        const int nig = WGM * nN, gid = wgid / nig, fm = gid * WGM, gsz = (nM - fm) < WGM ? (nM - fm) : WGM;
        u.pm = fm + ((wgid % nig) % gsz); u.pn = (wgid % nig) / gsz; return true;
    }
    __device__ __forceinline__ void a_ready(const Unit&) const {}
    __device__ __forceinline__ void done(const Unit&) const {}
};
__device__ __forceinline__ unsigned cvt_pk_bf16(float lo, float hi) { unsigned r; asm volatile("v_cvt_pk_bf16_f32 %0, %1, %2" : "=v"(r) : "v"(lo), "v"(hi)); return r; }
template <class Epi, class Sched, bool ALIGN_EPI = false, bool SP2 = false>
__device__ __forceinline__ void gemm_phase(PG8_LAS unsigned char* lds, const Gemm g, const Sched& S, const Epi& E) {
    const int tid = threadIdx.x, wid = __builtin_amdgcn_readfirstlane(tid >> 6), lane = tid & 63, wr = wid >> 2, wc = wid & 3, fr = lane & 15, fq = lane >> 4;
    const int K = g.K, nt = K / BK;
    unsigned voffA[2], voffB[2];
#pragma unroll
    for (int i = 0; i < 2; ++i) { int R, C; stage_rc(tid * 16 + i * 8192, R, C); const int Rb = Epi::PERM ? ((R & ~31) + perm32(R & 31)) : R;
        voffA[i] = (unsigned)(R * K + C) * 2u; voffB[i] = (unsigned)(Rb * K + C) * 2u; }
    const size_t kstep = (size_t)(BK * 2);
    const size_t hstep = (size_t)HALF * K * 2;
    const size_t tstep = 2 * hstep;
    const unsigned ldsw = (unsigned)wid * 1024u;
    const int aoff = lds_byte(wr * 64 + fr, fq * 8), boff = lds_byte(wc * 32 + fr, fq * 8);
#define PG8_SA(b, h) (((b) * 2 + (h)) * HTB)
#define PG8_SB(b, h) ((4 + (b) * 2 + (h)) * HTB)
#define PG8_STAGE(bufoff, gbase, voff) do { _Pragma("unroll") for (int _i = 0; _i < 2; ++_i) \
        __builtin_amdgcn_global_load_lds((const unsigned*)((const char*)(gbase) + (voff)[_i]), (PG8_LAS unsigned*)(lds + (bufoff) + ldsw + _i * 8192), 16, 0, 0); } while (0)
#define PG8_LDA(dst, b, h) do { _Pragma("unroll") for (int m = 0; m < 4; ++m) _Pragma("unroll") for (int k = 0; k < 2; ++k) dst[m][k] = *(const PG8_LAS bf16x8*)(lds + PG8_SA(b, h) + aoff + m * 2048 + k * 1024); } while (0)
#define PG8_LDB(dst, b, h) do { _Pragma("unroll") for (int n = 0; n < 2; ++n) _Pragma("unroll") for (int k = 0; k < 2; ++k) dst[n][k] = *(const PG8_LAS bf16x8*)(lds + PG8_SB(b, h) + boff + n * 2048 + k * 1024); } while (0)
#define PG8_MMA(ai, bj, At, Bt) do { __builtin_amdgcn_s_setprio(1); _Pragma("unroll") for (int m = 0; m < 4; ++m) _Pragma("unroll") for (int n = 0; n < 2; ++n) _Pragma("unroll") for (int k = 0; k < 2; ++k) \
        acc[ai][bj][m][n] = __builtin_amdgcn_mfma_f32_16x16x32_bf16(Bt[n][k], At[m][k], acc[ai][bj][m][n], 0, 0, 0); __builtin_amdgcn_s_setprio(0); } while (0)
#define PG8_WAIT_V(n) asm volatile("s_waitcnt vmcnt(" #n ")" ::: "memory")
#define PG8_WAIT_L(n) asm volatile("s_waitcnt lgkmcnt(" #n ")" ::: "memory")
#define PG8_BAR __builtin_amdgcn_s_barrier()
#define PG8_SCHED __builtin_amdgcn_sched_barrier(0)
    Unit cur, nxt; int ui = 0;
    if (!S.next(0, cur)) return;
    f32x4 acc[2][2][4][2];
#pragma unroll
    for (int a = 0; a < 2; ++a)
#pragma unroll
        for (int b = 0; b < 2; ++b)
#pragma unroll
            for (int m = 0; m < 4; ++m)
#pragma unroll
                for (int n = 0; n < 2; ++n) acc[a][b][m][n] = (f32x4){0.f, 0.f, 0.f, 0.f};
    bf16x8 At[4][2], B0[2][2], B1[2][2];
    const char* cA = (const char*)g.A + (size_t)cur.pm * tstep; const char* cB = (const char*)g.Bt + (size_t)cur.pn * tstep;
    S.a_ready(cur);
    if constexpr (SP2) {
        PG8_STAGE(PG8_SB(0, 0), cB, voffB); PG8_STAGE(PG8_SB(0, 1), cB + hstep, voffB); PG8_STAGE(PG8_SA(0, 0), cA, voffA); PG8_STAGE(PG8_SA(0, 1), cA + hstep, voffA);
        if (wr == 1) PG8_BAR;
        PG8_WAIT_V(2); PG8_BAR;
        PG8_STAGE(PG8_SB(1, 0), cB + kstep, voffB); PG8_STAGE(PG8_SA(1, 0), cA + kstep, voffA); PG8_STAGE(PG8_SB(1, 1), cB + hstep + kstep, voffB);
        PG8_WAIT_V(6); PG8_BAR;
    } else {
        PG8_STAGE(PG8_SB(0, 0), cB, voffB); PG8_STAGE(PG8_SA(0, 0), cA, voffA); PG8_STAGE(PG8_SB(0, 1), cB + hstep, voffB); PG8_STAGE(PG8_SA(0, 1), cA + hstep, voffA);
        if (wr == 1) PG8_BAR;
        PG8_WAIT_V(4); PG8_BAR;
        PG8_STAGE(PG8_SB(1, 0), cB + kstep, voffB); PG8_STAGE(PG8_SA(1, 0), cA + kstep, voffA); PG8_STAGE(PG8_SB(1, 1), cB + hstep + kstep, voffB);
        PG8_WAIT_V(6); PG8_BAR;
    }
    for (;;) {
        const bool has_next = S.next(ui + 1, nxt);
        const char* nA = has_next ? (const char*)g.A + (size_t)nxt.pm * tstep : cA; const char* nB = has_next ? (const char*)g.Bt + (size_t)nxt.pn * tstep : cB;
        for (int t = 0; t < nt; t += 2) {
            const bool last = (t == nt - 2);
            const char* a1 = cA + (size_t)(t + 1) * kstep;
            const char* a2 = last ? nA : cA + (size_t)(t + 2) * kstep; const char* b2 = last ? nB : cB + (size_t)(t + 2) * kstep;
            const char* a3 = a2 + kstep; const char* b3 = b2 + kstep;
            if (last && has_next) S.a_ready(nxt);
            if constexpr (SP2) {
            PG8_LDB(B0, 0, 0); PG8_LDB(B1, 0, 1); PG8_SCHED; PG8_LDA(At, 0, 0); PG8_STAGE(PG8_SA(1, 1), a1 + hstep, voffA);
            PG8_WAIT_V(8); PG8_WAIT_L(0); PG8_BAR; PG8_MMA(0, 0, At, B0); PG8_MMA(0, 1, At, B1); PG8_BAR; PG8_SCHED;
            PG8_LDA(At, 0, 1); PG8_STAGE(PG8_SB(0, 0), b2, voffB); PG8_STAGE(PG8_SB(0, 1), b2 + hstep, voffB); PG8_STAGE(PG8_SA(0, 0), a2, voffA);
            PG8_WAIT_V(8); PG8_WAIT_L(0); PG8_BAR; PG8_MMA(1, 0, At, B0); PG8_MMA(1, 1, At, B1); PG8_BAR; PG8_SCHED;
            PG8_LDB(B0, 1, 0); PG8_LDB(B1, 1, 1); PG8_SCHED; PG8_LDA(At, 1, 0); PG8_STAGE(PG8_SA(0, 1), a2 + hstep, voffA);
            PG8_WAIT_V(8); PG8_WAIT_L(0); PG8_BAR; PG8_MMA(0, 0, At, B0); PG8_MMA(0, 1, At, B1); PG8_BAR; PG8_SCHED;
            PG8_LDA(At, 1, 1); PG8_STAGE(PG8_SB(1, 0), b3, voffB); PG8_STAGE(PG8_SB(1, 1), b3 + hstep, voffB); PG8_STAGE(PG8_SA(1, 0), a3, voffA);
            PG8_WAIT_V(8); PG8_WAIT_L(0); PG8_BAR; PG8_MMA(1, 0, At, B0); PG8_MMA(1, 1, At, B1); PG8_BAR; PG8_SCHED;
            } else {
            PG8_LDB(B0, 0, 0); PG8_SCHED; PG8_LDA(At, 0, 0); PG8_STAGE(PG8_SA(1, 1), a1 + hstep, voffA);
            PG8_WAIT_L(8); PG8_BAR; PG8_WAIT_L(0); PG8_MMA(0, 0, At, B0); PG8_BAR; PG8_SCHED;
            PG8_LDB(B1, 0, 1); PG8_STAGE(PG8_SB(0, 0), b2, voffB);
            PG8_BAR; PG8_WAIT_L(0); PG8_MMA(0, 1, At, B1); PG8_BAR;
            PG8_LDA(At, 0, 1); PG8_STAGE(PG8_SA(0, 0), a2, voffA);
            PG8_BAR; PG8_WAIT_L(0); PG8_MMA(1, 0, At, B0); PG8_BAR; PG8_SCHED;
            PG8_STAGE(PG8_SB(0, 1), b2 + hstep, voffB);
            PG8_WAIT_V(6); PG8_BAR; PG8_MMA(1, 1, At, B1); PG8_BAR;
            PG8_LDB(B0, 1, 0); PG8_SCHED; PG8_LDA(At, 1, 0); PG8_STAGE(PG8_SA(0, 1), a2 + hstep, voffA);
            PG8_WAIT_L(8); PG8_BAR; PG8_WAIT_L(0); PG8_MMA(0, 0, At, B0); PG8_BAR; PG8_SCHED;
            PG8_LDB(B1, 1, 1); PG8_STAGE(PG8_SB(1, 0), b3, voffB);
            PG8_BAR; PG8_WAIT_L(0); PG8_MMA(0, 1, At, B1); PG8_BAR;
            PG8_LDA(At, 1, 1); PG8_STAGE(PG8_SA(1, 0), a3, voffA);
            PG8_BAR; PG8_WAIT_L(0); PG8_MMA(1, 0, At, B0); PG8_BAR; PG8_SCHED;
            PG8_STAGE(PG8_SB(1, 1), b3 + hstep, voffB);
            PG8_WAIT_V(6); PG8_BAR; PG8_MMA(1, 1, At, B1); PG8_BAR;
            }
        }
        if constexpr (ALIGN_EPI) { if (wr == 0) PG8_BAR; }
        if constexpr (!Epi::AFTER_DRAIN) { E(acc, cur, wr, wc, fr, fq); S.done(cur); }
        if (!has_next) break;
#pragma unroll
        for (int a = 0; a < 2; ++a)
#pragma unroll
            for (int b = 0; b < 2; ++b)
#pragma unroll
                for (int m = 0; m < 4; ++m)
#pragma unroll
                    for (int n = 0; n < 2; ++n) acc[a][b][m][n] = (f32x4){0.f, 0.f, 0.f, 0.f};
        cur = nxt; cA = nA; cB = nB; ++ui;
        if constexpr (ALIGN_EPI) { if (wr == 1) PG8_BAR; }
    }
    PG8_WAIT_V(0);
    if constexpr (!ALIGN_EPI) { if (wr == 0) PG8_BAR; }
    PG8_BAR;
    if constexpr (Epi::AFTER_DRAIN) { E.fused(acc, cur, wr, wc, fr, fq, lds, wid, lane); S.done(cur); }
#undef PG8_SA
#undef PG8_SB
#undef PG8_STAGE
#undef PG8_LDA
#undef PG8_LDB
#undef PG8_MMA
#undef PG8_WAIT_V
#undef PG8_WAIT_L
#undef PG8_BAR
#undef PG8_SCHED
}
}

using pg8::bf16_t; using pg8::f32x4; using pg8::u32x4; using pg8::Unit;
typedef short bf16x8 __attribute__((ext_vector_type(8)));
typedef float f32x16 __attribute__((ext_vector_type(16)));
typedef unsigned u32x2 __attribute__((ext_vector_type(2)));
#define LAS __attribute__((address_space(3)))

constexpr int TT = 32768, SEQ = 4096, DM = 1024, NPROJ = 1696, NPROJ_P = 1792, PROJ_LD = 768, QL = 384, KVL = 256, NQ = 768, DFF = 2816, PLE = 256;
constexpr int NHEAD = 8, CONVC = 512, CONVW = 31;
constexpr float EPS = 1e-6f;
constexpr float QSCALE = 0.10206207261596575f * 1.4426950408889634f;
constexpr size_t MiB = 1u << 20;
constexpr size_t WS_WIN = 1 * MiB, WS_WQ = 5 * MiB, WS_WK = 6 * MiB, WS_WV = 6 * MiB + 512 * 1024, WS_WO = 7 * MiB, WS_WG = 9 * MiB, WS_WU = 15 * MiB,
                 WS_WD = 21 * MiB, WS_WPP = 27 * MiB, WS_WPG = 28 * MiB, WS_CS = 30 * MiB, WS_RSTD = 34 * MiB, WS_CTL = 35 * MiB, WS_SLOT = 36 * MiB;
constexpr size_t CTL_BYTES = 4 * 128 * 256, BAR_BYTES = 16384, WS_BAR = WS_CTL + 4 * 128 * 256, FLAG_BYTES = 16384, WS_FLAG = WS_BAR + 16384, ROWSS_BYTES = 131072, WS_ROWSS = WS_FLAG + 16384, SLOT_BANK = (size_t)128 * 256 * 4 * 4;
constexpr size_t WS_XB = 40 * MiB, WS_PBF = 104 * MiB, WS_PROJ = 120 * MiB, WS_QAN = 232 * MiB, WS_KVAN = 256 * MiB, WS_CAT = 272 * MiB,
                 WS_GLU = 168 * MiB, WS_K = 336 * MiB, WS_Q = 120 * MiB, WS_VT = 168 * MiB, WS_ACT = 120 * MiB, WS_HALO = 296 * MiB, WS_H1B = 336 * MiB, WS_PE = 400 * MiB, WS_END = 472 * MiB;
constexpr int LDS_BYTES = 147456;
constexpr int NPHASE = 9;

struct Params {
    const float* x; const float* p; const int* pos;
    const float *g_mix_pre, *w_in, *g_q_a, *w_q_b, *g_kv_a, *w_kv_b, *conv_w, *conv_b, *conv_ln_g, *conv_ln_b, *w_o, *g_mix_post, *g_ffn_pre,
                *w_gate, *w_up, *dw_w, *dw_b, *w_down, *g_ffn_post, *w_ple_proj, *g_ple, *w_ple_gate;
    float* out; unsigned char* ws; int ph_lo, ph_hi;
};

__device__ __forceinline__ float bf_lo(unsigned w) { return __uint_as_float(w << 16); }
__device__ __forceinline__ float bf_hi(unsigned w) { return __uint_as_float(w & 0xffff0000u); }
__device__ __forceinline__ float bf1(bf16_t h) { return __uint_as_float((unsigned)h << 16); }
__device__ __forceinline__ unsigned pk2(float lo, float hi) { return pg8::cvt_pk_bf16(lo, hi); }
__device__ __forceinline__ float wave_sum(float v) {
#define WS_DPP(ctrl, rmask) v += __int_as_float(__builtin_amdgcn_update_dpp(0, __float_as_int(v), (ctrl), (rmask), 0xf, true))
    WS_DPP(0x111, 0xf); WS_DPP(0x112, 0xf); WS_DPP(0x114, 0xf); WS_DPP(0x118, 0xf);
    WS_DPP(0x142, 0xa);
    WS_DPP(0x143, 0xc);
#undef WS_DPP
    return __int_as_float(__builtin_amdgcn_readlane(__float_as_int(v), 63));
}
__device__ __forceinline__ float fast_sigmoid(float x) { return __builtin_amdgcn_rcpf(1.0f + __builtin_amdgcn_exp2f(-1.4426950408889634f * x)); }
__device__ __forceinline__ float gelu_tanh(float g) {
    const float u = 0.7978845608028654f * (g + 0.044715f * g * g * g);
    return g * __builtin_amdgcn_rcpf(1.0f + __builtin_amdgcn_exp2f(-2.0f * 1.4426950408889634f * u));
}
typedef float f32x2 __attribute__((ext_vector_type(2)));
__device__ __forceinline__ f32x2 fast_sigmoid2(f32x2 x) { const f32x2 z = x * (-1.4426950408889634f); f32x2 e; e.x = __builtin_amdgcn_exp2f(z.x); e.y = __builtin_amdgcn_exp2f(z.y);
    const f32x2 d = e + 1.0f; f32x2 r; r.x = __builtin_amdgcn_rcpf(d.x); r.y = __builtin_amdgcn_rcpf(d.y); return r; }
__device__ __forceinline__ f32x2 gelu_tanh2(f32x2 g) { const f32x2 t = (g * g) * 0.044715f + 1.0f; const f32x2 z = (g * t) * (-2.0f * 0.7978845608028654f * 1.4426950408889634f);
    f32x2 e; e.x = __builtin_amdgcn_exp2f(z.x); e.y = __builtin_amdgcn_exp2f(z.y); const f32x2 d = e + 1.0f; f32x2 r; r.x = __builtin_amdgcn_rcpf(d.x); r.y = __builtin_amdgcn_rcpf(d.y); return g * r; }
__device__ __forceinline__ void unpack8(const u32x4 w, float (&f)[8]) {
    f[0] = bf_lo(w.x); f[1] = bf_hi(w.x); f[2] = bf_lo(w.y); f[3] = bf_hi(w.y); f[4] = bf_lo(w.z); f[5] = bf_hi(w.z); f[6] = bf_lo(w.w); f[7] = bf_hi(w.w);
}
__device__ __forceinline__ u32x4 pack8(const float (&f)[8]) { u32x4 w; w.x = pk2(f[0], f[1]); w.y = pk2(f[2], f[3]); w.z = pk2(f[4], f[5]); w.w = pk2(f[6], f[7]); return w; }

struct EpiStore {
    static constexpr bool PERM = true, AFTER_DRAIN = false;
    bf16_t* O; long ldc; int lg; long S;
    __device__ __forceinline__ void operator()(const f32x4 (&acc)[2][2][4][2], const Unit& u, int wr, int wc, int fr, int fq) const {
        const int row0 = u.pm * 256 + wr * 64 + fr, c0 = u.pn * 256 + wc * 32 + 8 * fq;
#pragma unroll
        for (int bj = 0; bj < 2; ++bj) { const int c = c0 + bj * 128; const long dcol = (long)(c >> lg) * S + (c & ((1 << lg) - 1));
#pragma unroll
            for (int ai = 0; ai < 2; ++ai)
#pragma unroll
                for (int m = 0; m < 4; ++m) { const f32x4 v0 = acc[ai][bj][m][0], v1 = acc[ai][bj][m][1]; u32x4 w;
                    w.x = pk2(v0[0], v0[1]); w.y = pk2(v0[2], v0[3]); w.z = pk2(v1[0], v1[1]); w.w = pk2(v1[2], v1[3]);
                    *(u32x4*)(O + (long)(row0 + ai * 128 + m * 16) * ldc + dcol) = w; } }
    }
};
struct EpiProj {
    static constexpr bool PERM = true, AFTER_DRAIN = false;
    bf16_t* proj; bf16_t* glu;
    __device__ __forceinline__ void operator()(const f32x4 (&acc)[2][2][4][2], const Unit& u, int wr, int wc, int fr, int fq) const {
        const int row0 = u.pm * 256 + wr * 64 + fr, lc = wc * 32 + 8 * fq;
        if (u.pn < 3) {
#pragma unroll
            for (int bj = 0; bj < 2; ++bj)
#pragma unroll
                for (int ai = 0; ai < 2; ++ai)
#pragma unroll
                    for (int m = 0; m < 4; ++m) { const f32x4 v0 = acc[ai][bj][m][0], v1 = acc[ai][bj][m][1]; u32x4 w;
                        w.x = pk2(v0[0], v0[1]); w.y = pk2(v0[2], v0[3]); w.z = pk2(v1[0], v1[1]); w.w = pk2(v1[2], v1[3]);
                        *(u32x4*)(proj + (long)(row0 + ai * 128 + m * 16) * PROJ_LD + u.pn * 256 + bj * 128 + lc) = w; }
        } else {
#pragma unroll
            for (int ai = 0; ai < 2; ++ai)
#pragma unroll
                for (int m = 0; m < 4; ++m) { float o[8];
#pragma unroll
                    for (int e = 0; e < 8; e += 2) { const f32x2 a = {acc[ai][0][m][e >> 2][e & 3], acc[ai][0][m][(e + 1) >> 2][(e + 1) & 3]}, gt = {acc[ai][1][m][e >> 2][e & 3], acc[ai][1][m][(e + 1) >> 2][(e + 1) & 3]};
                        const f32x2 r = a * fast_sigmoid2(gt); o[e] = r.x; o[e + 1] = r.y; }
                    *(u32x4*)(glu + (long)(row0 + ai * 128 + m * 16) * CONVC + (u.pn - 3) * 128 + lc) = pack8(o); }
        }
    }
};
__device__ __forceinline__ float dpp_shr1(float old, float src) { return __int_as_float(__builtin_amdgcn_update_dpp(__float_as_int(old), __float_as_int(src), 0x111, 0xf, 0xf, false)); }
__device__ __forceinline__ float dpp_shr2(float old, float src) { return __int_as_float(__builtin_amdgcn_update_dpp(__float_as_int(old), __float_as_int(src), 0x112, 0xf, 0xf, false)); }
__device__ __forceinline__ float dpp_ror1(float src) { return __int_as_float(__builtin_amdgcn_update_dpp(0, __float_as_int(src), 0x121, 0xf, 0xf, false)); }
__device__ __forceinline__ float dpp_ror2(float src) { return __int_as_float(__builtin_amdgcn_update_dpp(0, __float_as_int(src), 0x122, 0xf, 0xf, false)); }
struct EpiGU {
    static constexpr bool PERM = true, AFTER_DRAIN = false;
    bf16_t* act; const float* dw; const float* db; float* halo; unsigned* flag; PG8_LAS float* E;
    template <int AI, int M>
    __device__ __forceinline__ void rows16(const f32x4 (&acc)[2][2][4][2], const float (&P1)[8], const float (&P2)[8], const float (&w0)[8], const float (&w1)[8], const float (&w2)[8], const float (&bb)[8],
                                           long row, int c, int fr) const {
        float o[8];
#pragma unroll
        for (int e = 0; e < 8; e += 2) { f32x2 g, g1, g2;
#pragma unroll
            for (int k = 0; k < 2; ++k) { const int ee = e + k; const float gv = acc[AI][0][M][ee >> 2][ee & 3];
                float s1, s2;
                if (M > 0) { const float pv = acc[AI][0][M > 0 ? M - 1 : 0][ee >> 2][ee & 3]; s1 = dpp_ror1(pv); s2 = dpp_ror2(pv); }
                else { s1 = P1[ee]; s2 = fr == 0 ? P2[ee] : P1[ee]; }
                g[k] = gv; g1[k] = dpp_shr1(s1, gv); g2[k] = dpp_shr2(s2, gv); }
            const f32x2 w0v = {w0[e], w0[e + 1]}, w1v = {w1[e], w1[e + 1]}, w2v = {w2[e], w2[e + 1]}, bv = {bb[e], bb[e + 1]};
            const f32x2 upv = {acc[AI][1][M][e >> 2][e & 3], acc[AI][1][M][(e + 1) >> 2][(e + 1) & 3]};
            const f32x2 cv = bv + w0v * g2 + w1v * g1 + w2v * g;
            const f32x2 ov = gelu_tanh2(cv) * upv; o[e] = ov.x; o[e + 1] = ov.y; }
        *(u32x4*)(act + row * DFF + c) = pack8(o);
    }
    __device__ __forceinline__ void operator()(const f32x4 (&acc)[2][2][4][2], const Unit& u, int wr, int wc, int fr, int fq) const {
        const int lc = wc * 32 + 8 * fq;
        const int c = u.pn * 128 + lc;
        if (fr >= 14) {
#pragma unroll
            for (int ai = 0; ai < 2; ++ai)
#pragma unroll
                for (int n = 0; n < 2; ++n) *(PG8_LAS f32x4*)(E + ((ai * 2 + wr) * 2 + (fr - 14)) * 128 + lc + 4 * n) = acc[ai][0][3][n];
            if (wr == 1) { float* hp = halo + ((size_t)(u.pm * 22 + u.pn) * 2 + (fr - 14)) * 128 + lc;
#pragma unroll
                for (int n = 0; n < 2; ++n)
#pragma unroll
                    for (int e = 0; e < 4; ++e) __hip_atomic_store(hp + 4 * n + e, acc[1][0][3][n][e], __ATOMIC_RELAXED, __HIP_MEMORY_SCOPE_AGENT); }
        }
        if (wr == 1) { asm volatile("s_waitcnt vmcnt(0)" ::: "memory");
            if ((fr | fq) == 0) __hip_atomic_fetch_add(flag + u.pm * 22 + u.pn, 1u, __ATOMIC_RELAXED, __HIP_MEMORY_SCOPE_AGENT); }
        float w0[8], w1[8], w2[8], bb[8];
#pragma unroll
        for (int e = 0; e < 8; ++e) { w0[e] = dw[c + e]; w1[e] = dw[DFF + c + e]; w2[e] = dw[2 * DFF + c + e]; bb[e] = db[c + e]; }
        const long rb = (long)u.pm * 256 + wr * 64 + fr;
        const float Z[8] = {0.f, 0.f, 0.f, 0.f, 0.f, 0.f, 0.f, 0.f};
        rows16<1, 1>(acc, Z, Z, w0, w1, w2, bb, rb + 128 + 16, c, fr); rows16<1, 2>(acc, Z, Z, w0, w1, w2, bb, rb + 128 + 32, c, fr); rows16<1, 3>(acc, Z, Z, w0, w1, w2, bb, rb + 128 + 48, c, fr);
        rows16<0, 1>(acc, Z, Z, w0, w1, w2, bb, rb + 16, c, fr); rows16<0, 2>(acc, Z, Z, w0, w1, w2, bb, rb + 32, c, fr); rows16<0, 3>(acc, Z, Z, w0, w1, w2, bb, rb + 48, c, fr);
        asm volatile("s_waitcnt lgkmcnt(0)" ::: "memory"); __builtin_amdgcn_s_barrier(); asm volatile("" ::: "memory");
        { float P1[8], P2[8]; const int blk = 2 + wr;
#pragma unroll
          for (int n = 0; n < 2; ++n) { const f32x4 a = *(const PG8_LAS f32x4*)(E + ((blk - 1) * 2 + 1) * 128 + lc + 4 * n), d = *(const PG8_LAS f32x4*)(E + ((blk - 1) * 2 + 0) * 128 + lc + 4 * n);
#pragma unroll
              for (int e = 0; e < 4; ++e) { P1[4 * n + e] = a[e]; P2[4 * n + e] = d[e]; } }
          rows16<1, 0>(acc, P1, P2, w0, w1, w2, bb, rb + 128, c, fr); }
        { float P1[8], P2[8];
          const bool need_halo = (wr == 0) && ((u.pm & 15) != 0);
          if (wr == 1) {
#pragma unroll
              for (int n = 0; n < 2; ++n) { const f32x4 a = *(const PG8_LAS f32x4*)(E + 1 * 128 + lc + 4 * n), d = *(const PG8_LAS f32x4*)(E + lc + 4 * n);
#pragma unroll
                  for (int e = 0; e < 4; ++e) { P1[4 * n + e] = a[e]; P2[4 * n + e] = d[e]; } }
          } else if (need_halo) { unsigned* fp = flag + (u.pm - 1) * 22 + u.pn; unsigned spins = 0;
              while ((unsigned)__builtin_amdgcn_readfirstlane(__hip_atomic_load(fp, __ATOMIC_RELAXED, __HIP_MEMORY_SCOPE_AGENT)) < 4u) { if (++spins > (1u << 22)) break; __builtin_amdgcn_s_sleep(1); }
              const float* hp = halo + ((size_t)((u.pm - 1) * 22 + u.pn) * 2) * 128 + lc;
#pragma unroll
              for (int e = 0; e < 8; ++e) { P1[e] = __hip_atomic_load(hp + 128 + e, __ATOMIC_RELAXED, __HIP_MEMORY_SCOPE_AGENT); P2[e] = __hip_atomic_load(hp + e, __ATOMIC_RELAXED, __HIP_MEMORY_SCOPE_AGENT); }
          } else {
#pragma unroll
              for (int e = 0; e < 8; ++e) { P1[e] = 0.f; P2[e] = 0.f; }
          }
          rows16<0, 0>(acc, P1, P2, w0, w1, w2, bb, rb, c, fr); }
    }
};
struct PanelSumsq {
    float* xbuf; unsigned* cnt; int panel0; float eps;
    __device__ __forceinline__ void run(const f32x4 (&v)[2][2][4][2], const Unit& u, int wr, int wc, int fr, int fq, PG8_LAS unsigned char* lds, int wid, int lane) const {
        publish(v, u, wr, wc, fr, fq, lds, wid, lane); finish(u, lds, wid, lane);
    }
    __device__ __forceinline__ void publish(const f32x4 (&v)[2][2][4][2], const Unit& u, int wr, int wc, int fr, int fq, PG8_LAS unsigned char* lds, int wid, int lane) const {
        PG8_LAS float* Pp = (PG8_LAS float*)lds;
#pragma unroll
        for (int ai = 0; ai < 2; ++ai)
#pragma unroll
            for (int m = 0; m < 4; ++m) { float q = 0.f;
#pragma unroll
                for (int bj = 0; bj < 2; ++bj)
#pragma unroll
                    for (int n = 0; n < 2; ++n) { const f32x4 x = v[ai][bj][m][n]; q += (x[0] * x[0] + x[1] * x[1]) + (x[2] * x[2] + x[3] * x[3]); }
                q += __shfl_xor(q, 16); q += __shfl_xor(q, 32);
                if (fq == 0) Pp[(ai * 128 + wr * 64 + m * 16 + fr) * 4 + wc] = q; }
        asm volatile("s_waitcnt lgkmcnt(0)" ::: "memory"); __builtin_amdgcn_s_barrier(); asm volatile("" ::: "memory");
        const int row = wid * 32 + (lane & 31); const int panel = panel0 + u.pm;
        if (lane < 32) { const float tot = (Pp[row * 4 + 0] + Pp[row * 4 + 1]) + (Pp[row * 4 + 2] + Pp[row * 4 + 3]);
            __hip_atomic_store(xbuf + ((size_t)(panel * 256 + row) * 4 + u.pn), tot, __ATOMIC_RELAXED, __HIP_MEMORY_SCOPE_AGENT); }
        asm volatile("s_waitcnt vmcnt(0)" ::: "memory");
        if (lane == 0) __hip_atomic_fetch_add(cnt + 64 * panel, 1u, __ATOMIC_RELAXED, __HIP_MEMORY_SCOPE_AGENT);
    }
    __device__ __forceinline__ void finish(const Unit& u, PG8_LAS unsigned char* lds, int wid, int lane) const {
        PG8_LAS float* S = (PG8_LAS float*)(lds + 4096);
        const int row = wid * 32 + (lane & 31); const int panel = panel0 + u.pm;
        if (wid == 0) {
            unsigned spins = 0;
            for (;;) { if ((unsigned)__builtin_amdgcn_readfirstlane(__hip_atomic_load(cnt + 64 * panel, __ATOMIC_RELAXED, __HIP_MEMORY_SCOPE_AGENT)) >= 32u) break;
                if (++spins > (1u << 22)) break;
                __builtin_amdgcn_s_sleep(2); }
            __builtin_amdgcn_fence(__ATOMIC_ACQUIRE, "agent");
        }
        asm volatile("s_waitcnt vmcnt(0) lgkmcnt(0)" ::: "memory"); __builtin_amdgcn_s_barrier(); asm volatile("" ::: "memory");
        if (lane < 32) { const float* slot = xbuf + (size_t)(panel * 256 + row) * 4; float t = 0.f;
#pragma unroll
            for (int k = 0; k < 4; ++k) t += __hip_atomic_load(slot + k, __ATOMIC_RELAXED, __HIP_MEMORY_SCOPE_AGENT);
            S[row] = __builtin_amdgcn_rsqf(t * (1.0f / 1024.0f) + eps); }
        asm volatile("s_waitcnt lgkmcnt(0)" ::: "memory"); __builtin_amdgcn_s_barrier(); asm volatile("" ::: "memory");
    }
};
struct EpiWo {
    static constexpr bool PERM = true, AFTER_DRAIN = false;
    const float* x; bf16_t* h1b; bf16_t* xn; const float* g_post; const float* g_pre; PanelSumsq st1, st2; PG8_LAS unsigned char* lds;
    __device__ __forceinline__ void operator()(f32x4 (&acc)[2][2][4][2], const Unit& u, int wr, int wc, int fr, int fq) const {
        const int wid = wr * 4 + wc, lane = fq * 16 + fr;
        const PG8_LAS float* S = (const PG8_LAS float*)(lds + 4096);
        const int col0 = u.pn * 256 + wc * 32 + 8 * fq;
        st1.publish(acc, u, wr, wc, fr, fq, lds, wid, lane);
        f32x4 X0[3][2][2];
#pragma unroll
        for (int m = 0; m < 3; ++m) { const size_t off = (size_t)(u.pm * 256 + wr * 64 + m * 16 + fr) * DM + col0;
#pragma unroll
            for (int bj = 0; bj < 2; ++bj)
#pragma unroll
                for (int n = 0; n < 2; ++n) X0[m][bj][n] = __builtin_nontemporal_load((const f32x4*)(x + off + bj * 128 + n * 4)); }
        st1.finish(u, lds, wid, lane);
#pragma unroll
        for (int ai = 0; ai < 2; ++ai)
#pragma unroll
            for (int m = 0; m < 4; ++m) { const int r = ai * 128 + wr * 64 + m * 16 + fr; const float rs = S[r]; const size_t off = (size_t)(u.pm * 256 + r) * DM + col0;
#pragma unroll
                for (int bj = 0; bj < 2; ++bj)
#pragma unroll
                    for (int n = 0; n < 2; ++n) { const f32x4 xv = (ai == 0 && m < 3) ? X0[m < 3 ? m : 0][bj][n] : __builtin_nontemporal_load((const f32x4*)(x + off + bj * 128 + n * 4)); const f32x4 g = *(const f32x4*)(g_post + col0 + bj * 128 + n * 4);
                        acc[ai][bj][m][n] = xv + acc[ai][bj][m][n] * rs * g; }
                asm volatile("" : "+v"(acc[ai][0][m][0]), "+v"(acc[ai][0][m][1]), "+v"(acc[ai][1][m][0]), "+v"(acc[ai][1][m][1]));
                if (m & 1) asm volatile("" ::: "memory"); }
        st2.publish(acc, u, wr, wc, fr, fq, lds, wid, lane);
#pragma unroll
        for (int ai = 0; ai < 2; ++ai)
#pragma unroll
            for (int m = 0; m < 4; ++m) { const size_t off = (size_t)(u.pm * 256 + ai * 128 + wr * 64 + m * 16 + fr) * DM + col0;
#pragma unroll
                for (int bj = 0; bj < 2; ++bj) { const f32x4 h0 = acc[ai][bj][m][0], h1 = acc[ai][bj][m][1];
                    u32x4 hw; hw.x = pk2(h0[0], h0[1]); hw.y = pk2(h0[2], h0[3]); hw.z = pk2(h1[0], h1[1]); hw.w = pk2(h1[2], h1[3]); *(u32x4*)(h1b + off + bj * 128) = hw; } }
        st2.finish(u, lds, wid, lane);
#pragma unroll
        for (int ai = 0; ai < 2; ++ai)
#pragma unroll
            for (int m = 0; m < 4; ++m) { const int r = ai * 128 + wr * 64 + m * 16 + fr; const float rs = S[r]; const size_t off = (size_t)(u.pm * 256 + r) * DM + col0;
#pragma unroll
                for (int bj = 0; bj < 2; ++bj) { const f32x4 h0 = acc[ai][bj][m][0], h1 = acc[ai][bj][m][1];
                    const f32x4 g0 = *(const f32x4*)(g_pre + col0 + bj * 128), g1 = *(const f32x4*)(g_pre + col0 + bj * 128 + 4); const f32x4 o0 = h0 * rs * g0, o1 = h1 * rs * g1;
                    u32x4 w; w.x = pk2(o0[0], o0[1]); w.y = pk2(o0[2], o0[3]); w.z = pk2(o1[0], o1[1]); w.w = pk2(o1[2], o1[3]); *(u32x4*)(xn + off + bj * 128) = w; }
                asm volatile("" ::: "memory"); }
    }
};
struct EpiDown {
    static constexpr bool PERM = true, AFTER_DRAIN = false;
    const bf16_t* res; bf16_t* xn; const float* g; PanelSumsq st; PG8_LAS unsigned char* lds;
    __device__ __forceinline__ void operator()(f32x4 (&acc)[2][2][4][2], const Unit& u, int wr, int wc, int fr, int fq) const {
        const int wid = wr * 4 + wc, lane = fq * 16 + fr;
        const PG8_LAS float* S = (const PG8_LAS float*)(lds + 4096);
        const int col0 = u.pn * 256 + wc * 32 + 8 * fq;
        st.publish(acc, u, wr, wc, fr, fq, lds, wid, lane);
        u32x4 R[2][4][2];
#pragma unroll
        for (int ai = 0; ai < 2; ++ai)
#pragma unroll
            for (int m = 0; m < 4; ++m) { const size_t off = (size_t)(u.pm * 256 + ai * 128 + wr * 64 + m * 16 + fr) * DM + col0;
#pragma unroll
                for (int bj = 0; bj < 2; ++bj) R[ai][m][bj] = __builtin_nontemporal_load((const u32x4*)(res + off + bj * 128)); }
        st.finish(u, lds, wid, lane);
#pragma unroll
        for (int ai = 0; ai < 2; ++ai)
#pragma unroll
            for (int m = 0; m < 4; ++m) { const int r = ai * 128 + wr * 64 + m * 16 + fr; const float rs = S[r]; const size_t off = (size_t)(u.pm * 256 + r) * DM + col0;
#pragma unroll
                for (int bj = 0; bj < 2; ++bj) { const f32x4 g0 = *(const f32x4*)(g + col0 + bj * 128), g1 = *(const f32x4*)(g + col0 + bj * 128 + 4);
                    float hv[8]; unpack8(R[ai][m][bj], hv);
                    const f32x4 a0 = acc[ai][bj][m][0] * rs * g0, a1 = acc[ai][bj][m][1] * rs * g1; float o[8];
#pragma unroll
                    for (int e = 0; e < 4; ++e) { o[e] = hv[e] + a0[e]; o[4 + e] = hv[4 + e] + a1[e]; }
                    *(u32x4*)(xn + off + bj * 128) = pack8(o); } }
    }
};
struct EpiPe {
    static constexpr bool PERM = true, AFTER_DRAIN = false;
    bf16_t* O; float* rowss;
    __device__ __forceinline__ void operator()(const f32x4 (&acc)[2][2][4][2], const Unit& u, int wr, int wc, int fr, int fq) const {
        const int row0 = u.pm * 256 + wr * 64 + fr, c0 = u.pn * 256 + wc * 32 + 8 * fq;
#pragma unroll
        for (int ai = 0; ai < 2; ++ai)
#pragma unroll
            for (int m = 0; m < 4; ++m) { const int row = row0 + ai * 128 + m * 16; float q = 0.f;
#pragma unroll
                for (int bj = 0; bj < 2; ++bj) { const f32x4 v0 = acc[ai][bj][m][0], v1 = acc[ai][bj][m][1]; u32x4 w;
                    q += (v0[0] * v0[0] + v0[1] * v0[1]) + (v0[2] * v0[2] + v0[3] * v0[3]) + (v1[0] * v1[0] + v1[1] * v1[1]) + (v1[2] * v1[2] + v1[3] * v1[3]);
                    w.x = pk2(v0[0], v0[1]); w.y = pk2(v0[2], v0[3]); w.z = pk2(v1[0], v1[1]); w.w = pk2(v1[2], v1[3]);
                    *(u32x4*)(O + (long)row * DM + c0 + bj * 128) = w; }
                q += __shfl_xor(q, 16); q += __shfl_xor(q, 32);
                if (fq == 0) atomicAdd(rowss + row, q); }
    }
};
struct EpiOut {
    static constexpr bool PERM = true, AFTER_DRAIN = false;
    float* out; const bf16_t* h2b; const bf16_t* pe; const float* rowss; const float* gple;
    __device__ __forceinline__ void operator()(const f32x4 (&acc)[2][2][4][2], const Unit& u, int wr, int wc, int fr, int fq) const {
        const int row0 = u.pm * 256 + wr * 64 + fr, c0 = u.pn * 256 + wc * 32 + 8 * fq;
#pragma unroll
        for (int bj = 0; bj < 2; ++bj) { const int c = c0 + bj * 128;
            const f32x4 ga = *(const f32x4*)(gple + c), gb = *(const f32x4*)(gple + c + 4);
#pragma unroll
            for (int ai = 0; ai < 2; ++ai) {
            u32x4 H[4], Q[4]; float R[4];
#pragma unroll
            for (int m = 0; m < 4; ++m) { const int row = row0 + ai * 128 + m * 16;
                H[m] = *(const u32x4*)(h2b + (long)row * DM + c); Q[m] = __builtin_nontemporal_load((const u32x4*)(pe + (long)row * DM + c)); R[m] = rowss[row]; }
            __builtin_amdgcn_sched_barrier(0);
#pragma unroll
            for (int m = 0; m < 4; ++m) { const int row = row0 + ai * 128 + m * 16; const float r = __builtin_amdgcn_rsqf(R[m] * (1.0f / DM) + EPS);
                float hv[8], pv[8]; unpack8(H[m], hv); unpack8(Q[m], pv);
                const f32x4 v0 = acc[ai][bj][m][0], v1 = acc[ai][bj][m][1]; f32x4 o0, o1;
#pragma unroll
                for (int e = 0; e < 4; e += 2) { const f32x2 s0 = fast_sigmoid2((f32x2){v0[e], v0[e + 1]}), s1 = fast_sigmoid2((f32x2){v1[e], v1[e + 1]});
                    const f32x2 e0 = (f32x2){pv[e], pv[e + 1]} * r * (f32x2){ga[e], ga[e + 1]}, e1 = (f32x2){pv[4 + e], pv[5 + e]} * r * (f32x2){gb[e], gb[e + 1]};
                    const f32x2 q0 = (f32x2){hv[e], hv[e + 1]} + s0 * e0, q1 = (f32x2){hv[4 + e], hv[5 + e]} + s1 * e1;
                    o0[e] = q0.x; o0[e + 1] = q0.y; o1[e] = q1.x; o1[e + 1] = q1.y; }
                float* op = out + (long)row * DM + c; *(f32x4*)op = o0; *(f32x4*)(op + 4) = o1; } } }
    }
};
template <class Epi>
__device__ __forceinline__ void run_gemm_fused(LAS unsigned char* lds, const bf16_t* A, const bf16_t* Bt, int K, int G, int c, const Epi& E) {
    pg8::Gemm g{A, Bt, 16384, DM, K}; pg8::StaticOrder S; S.init(16384, DM, G, c);
    pg8::gemm_phase<Epi, pg8::StaticOrder, false, true>(lds, g, S, E);
    __syncthreads();
}

template <class Epi>
__device__ __forceinline__ void run_gemm(LAS unsigned char* lds, const bf16_t* A, const bf16_t* Bt, int M, int N, int K, int G, int c, const Epi& E) {
    pg8::Gemm g{A, Bt, M, N, K}; pg8::StaticOrder S; S.init(M, N, G, c);
    pg8::gemm_phase<Epi, pg8::StaticOrder, true, true>(lds, g, S, E);
    __syncthreads();
}

__device__ __forceinline__ int src_col(int mode, int n) {
    if (mode == 1) { const int h = n / 96, w = n % 96; if (w < 64) return n; const int j = w - 64; return h * 96 + 64 + 16 * (j & 1) + (j >> 1); }
    if (mode == 2) return (n >> 6) * 128 + (n & 63);
    if (mode == 3) return (n >> 6) * 128 + 64 + (n & 63);
    if (mode == 4) return (n >> 8) * 128 + (n & 127);
    if (mode == 5) { if (n < 672) return n; if (n < 768) return -1; const int e = n - 768, k = e >> 8, w = e & 255; return 672 + (w >= 128 ? 512 : 0) + 128 * k + (w & 127); }
    return n;
}
__device__ __forceinline__ void transpose_item(const float* W, int K, int Nsrc, int Ndst, bf16_t* WT, LAS float* scr, int item, int lane, int mode, float mul = 1.0f) {
    const int nblk = Ndst / 32, kb = item / nblk, nb = item % nblk, k0 = 64 * kb, n0 = 32 * nb;
    const int sc = src_col(mode, n0 + (lane & 31));
    float tv[32];
#pragma unroll
    for (int i = 0; i < 32; ++i) { const int kk = 2 * i + (lane >> 5); tv[i] = sc >= 0 ? __builtin_nontemporal_load(W + (size_t)(k0 + kk) * Nsrc + sc) : 0.f; }
#pragma unroll
    for (int i = 0; i < 32; ++i) { const int kk = 2 * i + (lane >> 5); scr[kk * 33 + (lane & 31)] = tv[i] * mul; }
    asm volatile("s_waitcnt lgkmcnt(0)" ::: "memory");
    const int c = lane & 7;
#pragma unroll
    for (int j = 0; j < 4; ++j) { const int n = (lane >> 3) + 8 * j; const LAS float* s = scr + (8 * c) * 33 + n;
        u32x4 o; o.x = pk2(s[0 * 33], s[1 * 33]); o.y = pk2(s[2 * 33], s[3 * 33]); o.z = pk2(s[4 * 33], s[5 * 33]); o.w = pk2(s[6 * 33], s[7 * 33]);
        *(u32x4*)(WT + (size_t)(n0 + n) * K + k0 + 8 * c) = o; }
    asm volatile("s_waitcnt lgkmcnt(0)" ::: "memory");
}
__device__ __forceinline__ void load_row_f32(const float* rp, int lane, float (&v)[16]) {
#pragma unroll
    for (int j = 0; j < 2; ++j) { const f32x4 a = *(const f32x4*)(rp + 512 * j + 8 * lane), b = *(const f32x4*)(rp + 512 * j + 8 * lane + 4);
#pragma unroll
        for (int e = 0; e < 4; ++e) { v[8 * j + e] = a[e]; v[8 * j + 4 + e] = b[e]; } }
}
__device__ __forceinline__ void load_row_bf16(const bf16_t* rp, int lane, float (&v)[16]) {
#pragma unroll
    for (int j = 0; j < 2; ++j) { const u32x4 w = *(const u32x4*)(rp + 512 * j + 8 * lane); float f[8]; unpack8(w, f);
#pragma unroll
        for (int e = 0; e < 8; ++e) v[8 * j + e] = f[e]; }
}
__device__ __forceinline__ void store_row_bf16(bf16_t* rp, int lane, const float (&v)[16]) {
#pragma unroll
    for (int j = 0; j < 2; ++j) { float f[8];
#pragma unroll
        for (int e = 0; e < 8; ++e) f[e] = v[8 * j + e];
        *(u32x4*)(rp + 512 * j + 8 * lane) = pack8(f); }
}
__device__ __forceinline__ void store_row_f32(float* rp, int lane, const float (&v)[16]) {
#pragma unroll
    for (int j = 0; j < 2; ++j) { f32x4 a, b;
#pragma unroll
        for (int e = 0; e < 4; ++e) { a[e] = v[8 * j + e]; b[e] = v[8 * j + 4 + e]; }
        *(f32x4*)(rp + 512 * j + 8 * lane) = a; *(f32x4*)(rp + 512 * j + 8 * lane + 4) = b; }
}
__device__ __forceinline__ float sumsq16(const float (&v)[16]) { float s = 0.f;
#pragma unroll
    for (int e = 0; e < 16; ++e) s += v[e] * v[e];
    return s; }

__device__ __forceinline__ void phase_prologue(const Params& P, LAS unsigned char* lds, int vcu, int G, int wave, int lane) {
    unsigned char* ws = P.ws;
    LAS float* scr = (LAS float*)(lds + wave * 16384);
    const int gw = vcu * 8 + wave, NGW = G * 8;
    const int gt = gw * 64 + lane, NGT = NGW * 64;
    const int gw4 = vcu * 4 + (wave & 3), NGW4 = G * 4, gt4 = gw4 * 64 + lane, NGT4 = NGW4 * 64;
    if (wave >= 4) {
    constexpr int I0 = 16 * 56, I1 = 6 * 24, I2 = 4 * 16, I3 = 4 * 16, I4 = 16 * 32, I5 = 16 * 176, I6 = 0, I7 = 44 * 32, I8 = 4 * 32, I9 = 16 * 32;
    constexpr int NITEMS = I0 + I1 + I2 + I3 + I4 + I5 + I6 + I7 + I8 + I9;
    for (int it = gw4; it < NITEMS; it += NGW4) {
        int r = it;
        if (r < I0) { transpose_item(P.w_in, DM, NPROJ, NPROJ_P, (bf16_t*)(ws + WS_WIN), scr, r, lane, 5); continue; } r -= I0;
        if (r < I1) { transpose_item(P.w_q_b, QL, NQ, NQ, (bf16_t*)(ws + WS_WQ), scr, r, lane, 1, QSCALE); continue; } r -= I1;
        if (r < I2) { transpose_item(P.w_kv_b, KVL, 1024, 512, (bf16_t*)(ws + WS_WK), scr, r, lane, 2); continue; } r -= I2;
        if (r < I3) { transpose_item(P.w_kv_b, KVL, 1024, 512, (bf16_t*)(ws + WS_WV), scr, r, lane, 3); continue; } r -= I3;
        if (r < I4) { transpose_item(P.w_o, DM, DM, DM, (bf16_t*)(ws + WS_WO), scr, r, lane, 0); continue; } r -= I4;
        if (r < I5) { const int nb = r % 176; transpose_item((nb & 4) ? P.w_up : P.w_gate, DM, DFF, 2 * DFF, (bf16_t*)(ws + WS_WG), scr, r, lane, 4); continue; } r -= I5;
        if (r < I7) { transpose_item(P.w_down, DFF, DM, DM, (bf16_t*)(ws + WS_WD), scr, r, lane, 0); continue; } r -= I7;
        if (r < I8) { transpose_item(P.w_ple_proj, PLE, DM, DM, (bf16_t*)(ws + WS_WPP), scr, r, lane, 0); continue; } r -= I8;
        transpose_item(P.w_ple_gate, DM, DM, DM, (bf16_t*)(ws + WS_WPG), scr, r, lane, 0);
    }
    { float* cs = (float*)(ws + WS_CS);
      for (int i = gt4; i < TT * 16; i += NGT4) { const int t = i >> 4, k = i & 15;
          const float inv = exp2f(-(float)k * (13.287712379549449f / 16.0f));
          const float ang = (float)P.pos[t] * inv;
          const double rev = (double)ang * 0.15915494309189535; const float fr = (float)(rev - floor(rev));
          cs[2 * (size_t)i] = __builtin_amdgcn_cosf(fr); cs[2 * (size_t)i + 1] = __builtin_amdgcn_sinf(fr); } }
    }
    { constexpr int XN_SPLIT = 27648; const int lo = wave < 4 ? 0 : XN_SPLIT, hi_ = wave < 4 ? XN_SPLIT : TT;
      f32x4 g[4];
#pragma unroll
      for (int j = 0; j < 4; ++j) g[j] = *(const f32x4*)(P.g_mix_pre + 4 * lane + 256 * j);
      bf16_t* XB = (bf16_t*)(ws + WS_XB);
      for (int m = lo + gw4; m < hi_; m += 4 * NGW4) { f32x4 v[4][4];
#pragma unroll
          for (int u = 0; u < 4; ++u) { const int mm = m + u * NGW4 < hi_ ? m + u * NGW4 : m;
#pragma unroll
              for (int j = 0; j < 4; ++j) v[u][j] = __builtin_nontemporal_load((const f32x4*)(P.x + (size_t)mm * DM + 4 * lane + 256 * j)); }
#pragma unroll
          for (int u = 0; u < 4; ++u) { const int mm = m + u * NGW4; float ss = 0.f;
#pragma unroll
              for (int j = 0; j < 4; ++j) ss += (v[u][j][0] * v[u][j][0] + v[u][j][1] * v[u][j][1]) + (v[u][j][2] * v[u][j][2] + v[u][j][3] * v[u][j][3]);
              const float rstd = __builtin_amdgcn_rsqf(wave_sum(ss) * (1.0f / DM) + EPS);
              if (mm < hi_) {
#pragma unroll
                  for (int j = 0; j < 4; ++j) { const f32x4 o = v[u][j] * rstd * g[j]; u32x2 w; w.x = pk2(o[0], o[1]); w.y = pk2(o[2], o[3]);
                      *(u32x2*)(XB + (size_t)mm * DM + 4 * lane + 256 * j) = w; } } } } }
    { const f32x4* pp = (const f32x4*)P.p; u32x2* pb = (u32x2*)(ws + WS_PBF); constexpr int NCH = TT * PLE / 4;
      for (int i = gt; i < NCH; i += 4 * NGT) { f32x4 a[4];
#pragma unroll
          for (int u = 0; u < 4; ++u) a[u] = __builtin_nontemporal_load(pp + (i + u * NGT < NCH ? i + u * NGT : i));
#pragma unroll
          for (int u = 0; u < 4; ++u) if (i + u * NGT < NCH) { u32x2 o; o.x = pk2(a[u][0], a[u][1]); o.y = pk2(a[u][2], a[u][3]); pb[i + u * NGT] = o; } } }
}

__device__ __forceinline__ void phase_r1(const Params& P, LAS unsigned char* lds, int vcu, int G, int tid, int wave, int lane) {
    unsigned char* ws = P.ws;
    const bf16_t* proj = (const bf16_t*)(ws + WS_PROJ);
    bf16_t* qan = (bf16_t*)(ws + WS_QAN); bf16_t* kvan = (bf16_t*)(ws + WS_KVAN); bf16_t* Kb = (bf16_t*)(ws + WS_K); bf16_t* cat = (bf16_t*)(ws + WS_CAT);
    const float* cs = (const float*)(ws + WS_CS);
    LAS float* cbuf = (LAS float*)lds;
    for (int ch = vcu; ch < TT / 128; ch += G) {
        const int t0 = ch * 128;
        { const bool has_halo = (t0 & (SEQ - 1)) != 0;
#define R1_BAR() do { asm volatile("s_waitcnt lgkmcnt(0)" ::: "memory"); __builtin_amdgcn_s_barrier(); asm volatile("" ::: "memory"); } while (0)
          if (wave < 4) {
              const int tc = tid;
              f32x2 w2[CONVW];
              { const float* wp = P.conv_w + 2 * tc;
#pragma unroll
                for (int j = 0; j < CONVW; ++j) { w2[j] = *(const f32x2*)wp; wp += CONVC; asm volatile("" : "+v"(wp)); } }
              const f32x2 bias2 = *(const f32x2*)(P.conv_b + 2 * tc);
              const unsigned* pg = (const unsigned*)((const bf16_t*)(ws + WS_GLU) + 2 * tc);
              f32x2 win[38];
              { unsigned hv[30];
#pragma unroll
                for (int j = 0; j < 30; ++j) hv[j] = __builtin_nontemporal_load(pg + (size_t)(has_halo ? t0 - 30 + j : t0) * (CONVC / 2));
#pragma unroll
                for (int j = 0; j < 30; ++j) win[j] = has_halo ? (f32x2){bf_lo(hv[j]), bf_hi(hv[j])} : (f32x2){0.f, 0.f}; }
              unsigned nv[4][8];
#pragma unroll
              for (int q = 0; q < 4; ++q)
#pragma unroll
                  for (int u = 0; u < 8; ++u) nv[q][u] = __builtin_nontemporal_load(pg + (size_t)(t0 + 8 * q + u) * (CONVC / 2));
#define R1_STEP(g, sl) do { const int tg = t0 + 8 * (g); \
                  _Pragma("unroll") for (int u = 0; u < 8; ++u) win[30 + u] = (f32x2){bf_lo(nv[sl][u]), bf_hi(nv[sl][u])}; \
                  if ((g) + 4 < 16) { _Pragma("unroll") for (int u = 0; u < 8; ++u) nv[sl][u] = __builtin_nontemporal_load(pg + (size_t)(tg + 32 + u) * (CONVC / 2)); } \
                  LAS float* cb = cbuf + ((g) & 1) * 4096; \
                  _Pragma("unroll") for (int u = 0; u < 8; u += 2) { f32x2 a2 = bias2, b2 = bias2; \
                      _Pragma("unroll") for (int j = 0; j < CONVW; ++j) { a2 += w2[j] * win[u + j]; b2 += w2[j] * win[u + 1 + j]; } \
                      *(LAS f32x2*)(cb + u * 512 + 2 * tc) = a2; *(LAS f32x2*)(cb + (u + 1) * 512 + 2 * tc) = b2; __builtin_amdgcn_sched_barrier(0); } \
                  _Pragma("unroll") for (int j = 0; j < 30; ++j) win[j] = win[j + 8]; \
                  R1_BAR(); } while (0)
              for (int gb = 0; gb < 16; gb += 4) { R1_STEP(gb, 0); R1_STEP(gb + 1, 1); R1_STEP(gb + 2, 2); R1_STEP(gb + 3, 3); }
#undef R1_STEP
              R1_BAR();
          } else {
              float lg[8], lb[8], gq[8], gk[8];
#pragma unroll
              for (int e = 0; e < 8; ++e) { lg[e] = P.conv_ln_g[8 * lane + e]; lb[e] = P.conv_ln_b[8 * lane + e]; gq[e] = lane < 48 ? P.g_q_a[8 * lane + e] : 0.f; gk[e] = lane < 32 ? P.g_kv_a[8 * lane + e] : 0.f; }
              const int tb = t0 + (wave - 4) * 32;
              u32x4 bq[4][2], bk[4][2]; bf16_t b1[4][2], b2[4][2]; float bc[4][2], bs[4][2];
#define R1_BLOAD(sl, g) do { _Pragma("unroll") for (int k = 0; k < 2; ++k) { const int t = tb + 2 * (g) + k; const bf16_t* pr = proj + (size_t)t * PROJ_LD; const u32x4 z = {0u, 0u, 0u, 0u}; \
                      bq[sl][k] = lane < 48 ? __builtin_nontemporal_load((const u32x4*)(pr + 8 * lane)) : z; bk[sl][k] = lane < 32 ? __builtin_nontemporal_load((const u32x4*)(pr + QL + 8 * lane)) : z; \
                      b1[sl][k] = lane < 16 ? pr[QL + KVL + lane] : (bf16_t)0; b2[sl][k] = lane < 16 ? pr[QL + KVL + 16 + lane] : (bf16_t)0; \
                      bc[sl][k] = lane < 16 ? cs[((size_t)t * 16 + lane) * 2] : 0.f; bs[sl][k] = lane < 16 ? cs[((size_t)t * 16 + lane) * 2 + 1] : 0.f; } } while (0)
#define R1_BCOMP(sl, g) do { _Pragma("unroll") for (int k = 0; k < 2; ++k) { const int t = tb + 2 * (g) + k; \
                      float fq[8], fk[8]; unpack8(bq[sl][k], fq); unpack8(bk[sl][k], fk); float sq = 0.f, sk = 0.f; \
                      _Pragma("unroll") for (int e = 0; e < 8; ++e) { sq += fq[e] * fq[e]; sk += fk[e] * fk[e]; } \
                      const float rq = __builtin_amdgcn_rsqf(wave_sum(sq) * (1.0f / QL) + EPS), rk = __builtin_amdgcn_rsqf(wave_sum(sk) * (1.0f / KVL) + EPS); \
                      _Pragma("unroll") for (int e = 0; e < 8; ++e) { fq[e] = fq[e] * rq * gq[e]; fk[e] = fk[e] * rk * gk[e]; } \
                      if (lane < 48) *(u32x4*)(qan + (size_t)t * QL + 8 * lane) = pack8(fq); \
                      if (lane < 32) *(u32x4*)(kvan + (size_t)t * KVL + 8 * lane) = pack8(fk); \
                      { const float x1 = bf1(b1[sl][k]), x2 = bf1(b2[sl][k]); const unsigned o = pk2(x1 * bc[sl][k] - x2 * bs[sl][k], x1 * bs[sl][k] + x2 * bc[sl][k]); \
                        const int sh = 4 * (lane & 3); u32x4 kv4; \
                        kv4.x = (unsigned)__shfl((int)o, sh); kv4.y = (unsigned)__shfl((int)o, sh + 1); kv4.z = (unsigned)__shfl((int)o, sh + 2); kv4.w = (unsigned)__shfl((int)o, sh + 3); \
                        if (lane < 32) *(u32x4*)(Kb + (size_t)t * NQ + (lane >> 2) * 96 + 64 + 2 * sh) = kv4; } } } while (0)
#define R1_LN(gp) do { const LAS float* cb = cbuf + ((gp) & 1) * 4096; \
                  _Pragma("unroll") for (int k = 0; k < 2; ++k) { const int u = (wave - 4) * 2 + k; \
                      const LAS f32x4* rp = (const LAS f32x4*)(cb + u * 512 + 8 * lane); const f32x4 a = rp[0], b4 = rp[1]; float v[8]; \
                      _Pragma("unroll") for (int e = 0; e < 4; ++e) { v[e] = a[e]; v[4 + e] = b4[e]; } \
                      float sm = 0.f; _Pragma("unroll") for (int e = 0; e < 8; ++e) sm += v[e]; \
                      const float mean = wave_sum(sm) * (1.0f / CONVC); float q = 0.f; \
                      _Pragma("unroll") for (int e = 0; e < 8; ++e) { v[e] -= mean; q += v[e] * v[e]; } \
                      const float rstd = __builtin_amdgcn_rsqf(wave_sum(q) * (1.0f / CONVC) + EPS); \
                      _Pragma("unroll") for (int e = 0; e < 8; ++e) { const float y = v[e] * rstd * lg[e] + lb[e]; v[e] = y * fast_sigmoid(y); } \
                      *(u32x4*)(cat + (size_t)(t0 + 8 * (gp) + u) * DM + 512 + 8 * lane) = pack8(v); } } while (0)
#define R1_LSTEP(g, sl) do { if ((g) >= 1) R1_LN((g) - 1); R1_BCOMP(sl, g); if ((g) + 4 < 16) R1_BLOAD(sl, (g) + 4); R1_BAR(); } while (0)
              R1_BLOAD(0, 0); R1_BLOAD(1, 1); R1_BLOAD(2, 2); R1_BLOAD(3, 3);
              for (int gb = 0; gb < 16; gb += 4) { R1_LSTEP(gb, 0); R1_LSTEP(gb + 1, 1); R1_LSTEP(gb + 2, 2); R1_LSTEP(gb + 3, 3); }
              R1_LN(15); R1_BAR();
#undef R1_LSTEP
#undef R1_LN
#undef R1_BCOMP
#undef R1_BLOAD
          }
#undef R1_BAR
          __syncthreads();
        }
    }
}

constexpr int KROW = 208, VROW = 144, KBUF = 64 * KROW, VBUF = 64 * VROW, ABUF = KBUF + VBUF;
constexpr float ATT_THR = 8.0f;
__device__ __forceinline__ int crow(int r, int hi) { return (r & 3) + 8 * (r >> 2) + 4 * hi; }
__device__ __forceinline__ float max3f(float a, float b, float c) { return fmaxf(fmaxf(a, b), c); }
template <bool PRE>
__device__ __forceinline__ float attn_half(f32x16& c, const f32x16& b, f32x16& n, f32x16& o0, f32x16& o1, float& lsum, const LAS unsigned char* kn, const LAS unsigned char* kn2, const LAS unsigned char* vb,
                                           const bf16x8 (&qr)[6], const f32x16& negm, bf16x8& f0, bf16x8& f1) {
    float ps = 0.f, mxb;
    bf16x8 f2, va0, va1, vb0, vb1;
#define ATT_EXP(r) do { c[r] = __builtin_amdgcn_exp2f(c[r]); ps += c[r]; } while (0)
#define ATT_KRD(dst, d0) do { dst = *(const LAS bf16x8*)(kn + (d0) * 32); } while (0)
#define ATT_QKC(src, d0) do { n = __builtin_amdgcn_mfma_f32_32x32x16_bf16(src, qr[d0], (d0) == 0 ? negm : n, 0, 0, 0); } while (0)
#define ATT_FENCE() __builtin_amdgcn_sched_barrier(0)
    ATT_KRD(f2, 2); ATT_FENCE(); ATT_QKC(f0, 0); ATT_EXP(0); ATT_EXP(1); ATT_EXP(2); mxb = max3f(b[0], b[1], b[2]); mxb = max3f(mxb, b[3], b[4]); ATT_FENCE();
    ATT_KRD(f0, 3); ATT_FENCE(); ATT_QKC(f1, 1); ATT_EXP(3); ATT_EXP(4); ATT_EXP(5); mxb = max3f(mxb, b[5], b[6]); mxb = max3f(mxb, b[7], b[8]); ATT_FENCE();
    ATT_KRD(f1, 4); ATT_FENCE(); ATT_QKC(f2, 2); ATT_EXP(6); ATT_EXP(7); ATT_EXP(8); mxb = max3f(mxb, b[9], b[10]); ATT_FENCE();
    ATT_KRD(f2, 5); va0 = *(const LAS bf16x8*)(vb); va1 = *(const LAS bf16x8*)(vb + 32 * VROW); ATT_FENCE(); ATT_QKC(f0, 3); ATT_EXP(9); ATT_EXP(10); ATT_EXP(11); mxb = max3f(mxb, b[11], b[12]); ATT_FENCE();
    vb0 = *(const LAS bf16x8*)(vb + 32); vb1 = *(const LAS bf16x8*)(vb + 32 * VROW + 32); if (PRE) f0 = *(const LAS bf16x8*)(kn2); ATT_FENCE(); ATT_QKC(f1, 4); ATT_EXP(12); ATT_EXP(13); mxb = max3f(mxb, b[13], b[14]); ATT_FENCE();
    if (PRE) f1 = *(const LAS bf16x8*)(kn2 + 32); ATT_FENCE(); ATT_QKC(f2, 5); ATT_EXP(14); ATT_EXP(15); mxb = fmaxf(mxb, b[15]); ATT_FENCE();
#undef ATT_EXP
#undef ATT_KRD
#undef ATT_QKC
    lsum += ps;
    const float mxo = __shfl_xor(mxb, 32);
    { u32x4 pw; pw.x = pk2(c[0], c[1]); pw.y = pk2(c[2], c[3]); pw.z = pk2(c[4], c[5]); pw.w = pk2(c[6], c[7]); const bf16x8 pb = __builtin_bit_cast(bf16x8, pw);
      o0 = __builtin_amdgcn_mfma_f32_32x32x16_bf16(va0, pb, o0, 0, 0, 0); o1 = __builtin_amdgcn_mfma_f32_32x32x16_bf16(va1, pb, o1, 0, 0, 0); ATT_FENCE(); }
    { u32x4 pw; pw.x = pk2(c[8], c[9]); pw.y = pk2(c[10], c[11]); pw.z = pk2(c[12], c[13]); pw.w = pk2(c[14], c[15]); const bf16x8 pb = __builtin_bit_cast(bf16x8, pw);
      o0 = __builtin_amdgcn_mfma_f32_32x32x16_bf16(vb0, pb, o0, 0, 0, 0); o1 = __builtin_amdgcn_mfma_f32_32x32x16_bf16(vb1, pb, o1, 0, 0, 0); ATT_FENCE(); }
#undef ATT_FENCE
    return fmaxf(mxb, mxo);
}
__device__ __forceinline__ void attn_unit(int b, int h, int qb, const bf16_t* Q, const bf16_t* K, const bf16_t* Vt, const float* cs, bf16_t* O, LAS unsigned char* lds, int tid, int wid, int lane) {
    const int r32 = lane & 31, hi = lane >> 5;
    const int q0 = qb * 256, qrow = q0 + wid * 32 + r32; const long tok = (long)b * SEQ + qrow;
    bf16x8 qr[6];
#pragma unroll
    for (int d0 = 0; d0 < 6; ++d0) qr[d0] = *(const bf16x8*)(Q + tok * NQ + h * 96 + d0 * 16 + hi * 8);
#pragma unroll
    for (int d0 = 4; d0 < 6; ++d0) { const int i0 = 8 * (d0 - 4) + 4 * hi; const f32x4* tp = (const f32x4*)(cs + (tok * 16 + i0) * 2); const f32x4 a = tp[0], c = tp[1];
        float f[8]; unpack8(__builtin_bit_cast(u32x4, qr[d0]), f); float g[8];
        g[0] = f[0] * a[0] - f[1] * a[1]; g[1] = f[0] * a[1] + f[1] * a[0]; g[2] = f[2] * a[2] - f[3] * a[3]; g[3] = f[2] * a[3] + f[3] * a[2];
        g[4] = f[4] * c[0] - f[5] * c[1]; g[5] = f[4] * c[1] + f[5] * c[0]; g[6] = f[6] * c[2] - f[7] * c[3]; g[7] = f[6] * c[3] + f[7] * c[2];
        qr[d0] = __builtin_bit_cast(bf16x8, pack8(g)); }
    const bf16_t* Kh = K + (long)b * SEQ * NQ + h * 96;
    const bf16_t* Vh = Vt + ((long)b * 512 + h * 64) * SEQ;
    const int kr0 = tid / 12, kc0 = tid % 12, kr1 = (tid + 512) / 12, kc1 = (tid + 512) % 12; const bool k1 = tid < 256;
    const int vr = tid >> 3, vc = tid & 7;
    unsigned kvo0 = (unsigned)(kr0 * NQ + kc0 * 8) * 2u, kvo1 = (unsigned)(kr1 * NQ + kc1 * 8) * 2u, vvo = (unsigned)(vr * SEQ + vc * 8) * 2u;
    unsigned ksto0 = (unsigned)(kr0 * KROW + kc0 * 16), ksto1 = (unsigned)(kr1 * KROW + kc1 * 16), vsto = (unsigned)(KBUF + vr * VROW + (vc >> 1) * 32 + (vc & 1) * 8);
    unsigned kbase = (unsigned)(r32 * KROW + hi * 16), vbase = (unsigned)(KBUF + r32 * VROW + hi * 16);
    asm volatile("" : "+v"(kvo0), "+v"(kvo1), "+v"(vvo), "+v"(ksto0), "+v"(ksto1), "+v"(vsto), "+v"(kbase), "+v"(vbase));
    const int NT = 4 * (qb + 1);
    u32x4 sk0, sk1 = {0u, 0u, 0u, 0u}, sv;
#define ATT_LOAD(t) do { const char* kt_ = (const char*)(Kh + (long)(64 * (t)) * NQ); const char* vt_ = (const char*)(Vh + 64 * (t)); \
        sk0 = *(const u32x4*)(kt_ + kvo0); if (k1) sk1 = *(const u32x4*)(kt_ + kvo1); sv = *(const u32x4*)(vt_ + vvo); } while (0)
#define ATT_STORE(boff) do { LAS unsigned char* kb_ = lds + (boff); *(LAS u32x4*)(kb_ + ksto0) = sk0; if (k1) *(LAS u32x4*)(kb_ + ksto1) = sk1; \
        { LAS unsigned char* vp_ = kb_ + vsto; u32x2 lo_ = {sv.x, sv.y}, hi_ = {sv.z, sv.w}; *(LAS u32x2*)vp_ = lo_; *(LAS u32x2*)(vp_ + 16) = hi_; } } while (0)
    ATT_LOAD(0); ATT_STORE(0);
    ATT_LOAD(1); ATT_STORE(ABUF);
    __syncthreads();
    f32x16 o0 = {}, o1 = {};
    float m_ref = 0.f, lsum = 0.f;
    const int wq_lo = q0 + wid * 32, wq_hi = wq_lo + 31;
    f32x16 pa, pb, pc, negm = {};
#define ATT_DECIDE(mx, X, Y) do { if (__any((mx) > ATT_THR)) { \
            const float d_ = fmaxf((mx), 0.f); const float alpha = __builtin_amdgcn_exp2f(-d_); m_ref += d_; lsum *= alpha; \
            _Pragma("unroll") for (int r = 0; r < 16; ++r) { o0[r] *= alpha; o1[r] *= alpha; X[r] -= d_; Y[r] -= d_; negm[r] = -m_ref; } } } while (0)
#define ATT_MASK(X, hs) do { if (32 * (hs) + 31 > wq_lo) { const int kv0 = 32 * (hs); \
            _Pragma("unroll") for (int r = 0; r < 16; ++r) { if (kv0 + crow(r, hi) > qrow) X[r] = -INFINITY; } } } while (0)
    { const f32x16 zero = {};
#pragma unroll
      for (int d0 = 0; d0 < 6; ++d0) { const bf16x8 a0 = *(const LAS bf16x8*)(lds + kbase + d0 * 32); pa = __builtin_amdgcn_mfma_f32_32x32x16_bf16(a0, qr[d0], d0 == 0 ? zero : pa, 0, 0, 0); }
#pragma unroll
      for (int d0 = 0; d0 < 6; ++d0) { const bf16x8 a0 = *(const LAS bf16x8*)(lds + kbase + 32 * KROW + d0 * 32); pb = __builtin_amdgcn_mfma_f32_32x32x16_bf16(a0, qr[d0], d0 == 0 ? zero : pb, 0, 0, 0); }
      ATT_MASK(pa, 0);
      float mx = fmaxf(pa[0], pa[1]);
#pragma unroll
      for (int r = 2; r < 16; r += 2) mx = max3f(mx, pa[r], pa[r + 1]);
      mx = fmaxf(mx, __shfl_xor(mx, 32));
      ATT_DECIDE(mx, pa, pb); }
#define ATT_HSTEP(C, B, N, hs, KN, KN2, VB, PRE) do { \
        if (32 * (hs) <= wq_hi) { \
            if (((hs) & 1) == 0) { kf0 = *(const LAS bf16x8*)(KN); kf1 = *(const LAS bf16x8*)((KN) + 32); } \
            const bool needb_ = 32 * ((hs) + 1) <= wq_hi; \
            if (needb_) ATT_MASK(B, (hs) + 1); \
            const float mx_ = attn_half<PRE>(C, B, N, o0, o1, lsum, (KN), (KN2), (VB), qr, negm, kf0, kf1); \
            if (needb_) ATT_DECIDE(mx_, B, N); \
        } } while (0)
#define ATT_TILE(t, CUR, NXT, NN, A0, A1, A2) do { \
        if ((t) + 2 < NT) ATT_LOAD((t) + 2); \
        ATT_HSTEP(A0, A1, A2, 2 * (t), lds + (NXT) * ABUF + kbase, lds + (NXT) * ABUF + kbase + 32 * KROW, lds + (CUR) * ABUF + vbase, true); \
        ATT_HSTEP(A1, A2, A0, 2 * (t) + 1, lds + (NXT) * ABUF + kbase + 32 * KROW, lds, lds + (CUR) * ABUF + vbase + 64, false); \
        if ((t) + 2 < NT) ATT_STORE((NN) * ABUF); \
        __syncthreads(); } while (0)
    bf16x8 kf0 = {}, kf1 = {};
    for (int t = 0; t < NT; t += 3) {
        ATT_TILE(t, 0, 1, 2, pa, pb, pc);
        if (t + 1 >= NT) break;
        ATT_TILE(t + 1, 1, 2, 0, pc, pa, pb);
        if (t + 2 >= NT) break;
        ATT_TILE(t + 2, 2, 0, 1, pb, pc, pa);
    }
#undef ATT_TILE
#undef ATT_HSTEP
#undef ATT_MASK
#undef ATT_DECIDE
#undef ATT_LOAD
#undef ATT_STORE
    lsum += __shfl_xor(lsum, 32);
    const float inv = 1.0f / lsum;
    bf16_t* op = O + tok * DM + h * 64;
#pragma unroll
    for (int g = 0; g < 4; ++g) {
        u32x2 a, d; a.x = pk2(o0[4 * g] * inv, o0[4 * g + 1] * inv); a.y = pk2(o0[4 * g + 2] * inv, o0[4 * g + 3] * inv);
        d.x = pk2(o1[4 * g] * inv, o1[4 * g + 1] * inv); d.y = pk2(o1[4 * g + 2] * inv, o1[4 * g + 3] * inv);
        *(u32x2*)(op + 8 * g + 4 * hi) = a; *(u32x2*)(op + 32 + 8 * g + 4 * hi) = d;
    }
}
__device__ __forceinline__ void phase_attn(const Params& P, LAS unsigned char* lds, int vcu, int G, int tid, int wave, int lane) {
    unsigned char* ws = P.ws;
    const bf16_t* Q = (const bf16_t*)(ws + WS_Q); const bf16_t* K = (const bf16_t*)(ws + WS_K); const bf16_t* Vt = (const bf16_t*)(ws + WS_VT); bf16_t* O = (bf16_t*)(ws + WS_CAT);
    for (int v = vcu; v < 256; v += G) {
        const int bh = v >> 2, j = v & 3;
        for (int i = 0; i < 4; ++i) { const int qb = (i == 0) ? 15 - 2 * j : (i == 1) ? 2 * j : (i == 2) ? 14 - 2 * j : 2 * j + 1;
            attn_unit(bh >> 3, bh & 7, qb, Q, K, Vt, (const float*)(ws + WS_CS), O, lds, tid, wave, lane); }
    }
}

#define XB_TMO      128
#define XB_XCNT(j)  (256  + 64 * (j))
#define XB_XSUB(j)  (1280 + 64 * (j))
#define XB_XGEN(j)  (2304 + 64 * (j))
#define XB_TOP      3328
#define XB_TOPGEN   3392
#define XCD_BAR_WORDS 3456
#define XB_SPIN_CAP (1u << 18)

__device__ __forceinline__ unsigned xb_ld(unsigned* p)              { return __hip_atomic_load(p, __ATOMIC_RELAXED, __HIP_MEMORY_SCOPE_AGENT); }
__device__ __forceinline__ unsigned xb_add(unsigned* p, unsigned v) { return __hip_atomic_fetch_add(p, v, __ATOMIC_RELAXED, __HIP_MEMORY_SCOPE_AGENT); }
__device__ __forceinline__ unsigned xb_xcc_id() { return (unsigned)__builtin_amdgcn_s_getreg((3 << 11) | 20) & 0xFu; }
#define XB_SPIN(cond, bar) do { unsigned _sp = 0; while (cond) { __builtin_amdgcn_s_sleep(1); \
    if ((++_sp & 255u) == 0u) { if (xb_ld(&(bar)[XB_TMO])) break; if (_sp > XB_SPIN_CAP) { atomicAdd(&(bar)[XB_TMO], 1u); break; } } } } while (0)

struct XcdBarrier {
    unsigned* bar; unsigned x;
    volatile LAS unsigned* st;
};

__device__ __forceinline__ XcdBarrier xcd_barrier_post(unsigned* bar, volatile LAS unsigned* st) {
    XcdBarrier b; b.bar = bar; b.x = xb_xcc_id(); b.st = st;
    if (threadIdx.x == 0) (void)xb_add(&bar[XB_XCNT(b.x)], 1u);
    return b;
}
__device__ __forceinline__ void xcd_barrier_complete(unsigned* bar, unsigned x, unsigned& nloc, unsigned& nx) {
    const unsigned G = gridDim.x * gridDim.y * gridDim.z;
    unsigned sum, cnt, mine, sp = 0u;
    for (;;) {
        sum = 0u; cnt = 0u; mine = 0u;
#pragma unroll
        for (unsigned j = 0; j < 16; ++j) { const unsigned c = xb_ld(&bar[XB_XCNT(j)]); sum += c; cnt += (c > 0u) ? 1u : 0u; mine = (j == x) ? c : mine; }
        if (sum == G) break;
        __builtin_amdgcn_s_sleep(1);
        if ((++sp & 255u) == 0u) { if (xb_ld(&bar[XB_TMO])) break; if (sp > XB_SPIN_CAP) { atomicAdd(&bar[XB_TMO], 1u); break; } }
    }
    nloc = mine > 0u ? mine : 1u; nx = cnt > 0u ? cnt : 1u;
}

__device__ __forceinline__ void xcd_barrier(const XcdBarrier& b) {
    asm volatile("s_waitcnt vmcnt(0)" ::: "memory");
    __syncthreads();
    if (threadIdx.x == 0) {
        unsigned* bar = b.bar;
        __builtin_amdgcn_s_waitcnt(0);
        unsigned nloc = b.st[0], nx = b.st[1];
        if (nloc == 0u) { xcd_barrier_complete(bar, b.x, nloc, nx); b.st[0] = nloc; b.st[1] = nx; }
        const unsigned old = xb_add(&bar[XB_XSUB(b.x)], 1u);
        const unsigned gen = old / nloc;
        if (old + 1u == (gen + 1u) * nloc) {
            __builtin_amdgcn_fence(__ATOMIC_RELEASE, "agent");
            asm volatile("s_waitcnt vmcnt(0)" ::: "memory");
            const unsigned og = xb_add(&bar[XB_TOP], 1u);
            const unsigned tg = og / nx;
            if (og + 1u == (tg + 1u) * nx) xb_add(&bar[XB_TOPGEN], 1u);
            else XB_SPIN(xb_ld(&bar[XB_TOPGEN]) == tg, bar);
            __builtin_amdgcn_fence(__ATOMIC_ACQUIRE, "agent");
            xb_add(&bar[XB_XGEN(b.x)], 1u);
            asm volatile("s_waitcnt vmcnt(0)" ::: "memory");
        } else {
            XB_SPIN(xb_ld(&bar[XB_XGEN(b.x)]) == gen, bar);
            __builtin_amdgcn_fence(__ATOMIC_ACQUIRE, "agent");
            asm volatile("s_waitcnt vmcnt(0)" ::: "memory");
        }
    }
    __syncthreads();
}

__global__ void __launch_bounds__(512) hymba_fwd(Params P) {
    extern __shared__ __attribute__((aligned(16))) unsigned char lds_raw[];
    LAS unsigned char* lds = (LAS unsigned char*)lds_raw;
    const int tid = threadIdx.x, lane = tid & 63, wave = __builtin_amdgcn_readfirstlane(tid >> 6);
    const int G = gridDim.x, bx = blockIdx.x;
    const int vcu = (G % 8 == 0) ? (bx % 8) * (G / 8) + bx / 8 : bx;
    unsigned char* ws = P.ws;
    bf16_t* XB = (bf16_t*)(ws + WS_XB);
    const int lo = P.ph_lo, hi = P.ph_hi;
    volatile LAS unsigned* bst = (volatile LAS unsigned*)(lds + 131072 + 512);
    if (tid < 2) bst[tid] = 0u;
    __syncthreads();
    XcdBarrier bar; bar.bar = (unsigned*)(ws + WS_BAR); bar.x = 0; bar.st = bst;
#ifndef PHASE_MASK
#define PHASE_MASK 0x1FF
#endif
#ifndef REP_MASK
#define REP_MASK 0x000
#endif
#define IN(k) ((((PHASE_MASK) >> (k)) & 1) && lo <= (k) && (k) < hi)
#define SEAM(k) do { if (IN(k) && IN((k) + 1)) { if ((k) == 0) cg::this_grid().sync(); else xcd_barrier(bar); } } while (0)
    if (IN(0)) { phase_prologue(P, lds, vcu, G, wave, lane);
        { u32x4* zc = (u32x4*)(ws + WS_CTL); const u32x4 z = {0u, 0u, 0u, 0u}; const int gtz = (vcu * 8 + wave) * 64 + lane;
          for (int i = gtz; i < (int)((CTL_BYTES + BAR_BYTES + FLAG_BYTES + ROWSS_BYTES) / 16); i += G * 512) zc[i] = z; }
        __syncthreads(); } SEAM(0);
    if (hi - lo > 1) bar = xcd_barrier_post((unsigned*)(ws + WS_BAR), bst);
    if (IN(1)) { { EpiProj E{(bf16_t*)(ws + WS_PROJ), (bf16_t*)(ws + WS_GLU)};
          run_gemm(lds, XB, (const bf16_t*)(ws + WS_WIN), TT, NPROJ_P, DM, G, bx, E); }
        { const bool hiw = bx >= G / 2; const size_t ro = hiw ? 0 : 24576;
          EpiPe E{(bf16_t*)(ws + WS_PE) + ro * DM, (float*)(ws + WS_ROWSS) + ro};
          run_gemm(lds, (const bf16_t*)(ws + WS_PBF) + ro * PLE, (const bf16_t*)(ws + WS_WPP), hiw ? 24576 : 8192, DM, PLE, G / 2, hiw ? bx - G / 2 : bx, E); }
    } SEAM(1);
    if (IN(2)) { phase_r1(P, lds, vcu, G, tid, wave, lane); } SEAM(2);
    if (IN(3)) {
#pragma nounroll
        for (int gi = 0; gi < 3; ++gi) {
            const bf16_t* A = (const bf16_t*)(ws + (gi == 0 ? WS_QAN : gi == 1 ? WS_KVAN : WS_WV));
            const bf16_t* Bt = (const bf16_t*)(ws + (gi == 0 ? WS_WQ : gi == 1 ? WS_WK : WS_KVAN));
            const int M = gi == 2 ? 512 : TT, N = gi == 0 ? NQ : gi == 1 ? 512 : TT, K = gi == 0 ? QL : KVL;
            EpiStore E{(bf16_t*)(ws + (gi == 0 ? WS_Q : gi == 1 ? WS_K : WS_VT)), gi == 2 ? (long)SEQ : (long)NQ, gi == 0 ? 30 : gi == 1 ? 6 : 12, gi == 1 ? 96L : gi == 2 ? 512L * SEQ : 0L};
            const bool upk = gi == 1; const bool hiw = bx >= G / 2;
            run_gemm(lds, A, Bt, (upk && !hiw) ? 0 : M, N, K, upk ? G / 2 : G, (upk && hiw) ? bx - G / 2 : bx, E);
        }
    } SEAM(3);
    if (IN(4)) { phase_attn(P, lds, vcu, G, tid, wave, lane); } SEAM(4);
    if (IN(5)) {
        PanelSumsq s1{(float*)(ws + WS_SLOT), (unsigned*)(ws + WS_CTL), 0, EPS}, s2{(float*)(ws + WS_SLOT + SLOT_BANK), (unsigned*)(ws + WS_CTL) + 128 * 64, 0, EPS};
        EpiWo E{P.x, (bf16_t*)(ws + WS_H1B), XB, P.g_mix_post, P.g_ffn_pre, s1, s2, lds + 131072 + 5120};
        run_gemm(lds, (const bf16_t*)(ws + WS_CAT), (const bf16_t*)(ws + WS_WO), TT, DM, DM, G, bx, E);
    } SEAM(5);
    if (IN(6)) { EpiGU E{(bf16_t*)(ws + WS_ACT), P.dw_w, P.dw_b, (float*)(ws + WS_HALO), (unsigned*)(ws + WS_FLAG), (PG8_LAS float*)(lds + 131072 + 1024)};
        run_gemm(lds, XB, (const bf16_t*)(ws + WS_WG), TT, 2 * DFF, DM, G, bx, E); } SEAM(6);
    if (IN(7)) {
        PanelSumsq s3{(float*)(ws + WS_SLOT + 2 * SLOT_BANK), (unsigned*)(ws + WS_CTL) + 2 * 128 * 64, 0, EPS};
        EpiDown E{(const bf16_t*)(ws + WS_H1B), XB, P.g_ffn_post, s3, lds + 131072 + 5120};
        run_gemm(lds, (const bf16_t*)(ws + WS_ACT), (const bf16_t*)(ws + WS_WD), TT, DM, DFF, G, bx, E);
    } SEAM(7);
    if (IN(8)) { EpiOut E{P.out, XB, (const bf16_t*)(ws + WS_PE), (const float*)(ws + WS_ROWSS), P.g_ple};
        run_gemm(lds, XB, (const bf16_t*)(ws + WS_WPG), TT, DM, DM, G, bx, E); }
#undef IN
#undef SEAM
}

#ifndef N_LAUNCHES
#define N_LAUNCHES 1
#endif
extern "C" void kernel_launch(void* const* d_in, const int* in_sizes, int n_in, void* d_out, int out_size, void* d_ws, size_t ws_size, hipStream_t stream) {
    static int grid = 0;
    if (grid == 0) {
        if (n_in != 25 || in_sizes[0] != TT * DM || out_size != TT * DM || ws_size < WS_END) {
            fprintf(stderr, "kernel_launch: unexpected problem: n_in %d in0 %d out %d ws %zu (need %zu)\n", n_in, n_in > 0 ? in_sizes[0] : -1, out_size, ws_size, (size_t)WS_END); grid = -1; return; }
        int dev = 0, cus = 0, per_cu = 0;
        hipGetDevice(&dev); hipDeviceGetAttribute(&cus, hipDeviceAttributeMultiprocessorCount, dev);
        if (hipFuncSetAttribute((const void*)hymba_fwd, hipFuncAttributeMaxDynamicSharedMemorySize, LDS_BYTES) != hipSuccess) { fprintf(stderr, "kernel_launch: hipFuncSetAttribute failed\n"); grid = -1; return; }
        if (hipOccupancyMaxActiveBlocksPerMultiprocessor(&per_cu, (const void*)hymba_fwd, 512, LDS_BYTES) != hipSuccess || per_cu < 1) { fprintf(stderr, "kernel_launch: occupancy query says %d\n", per_cu); per_cu = 1; }
        (void)hipGetLastError();
        grid = 256;
        if (cus != 256) fprintf(stderr, "kernel_launch: device has %d CUs, kernel is built for 256\n", cus);
    }
    if (grid < 0) return;
    Params a{};
    a.x = (const float*)d_in[0]; a.p = (const float*)d_in[1]; a.pos = (const int*)d_in[2];
    a.g_mix_pre = (const float*)d_in[3]; a.w_in = (const float*)d_in[4]; a.g_q_a = (const float*)d_in[5]; a.w_q_b = (const float*)d_in[6];
    a.g_kv_a = (const float*)d_in[7]; a.w_kv_b = (const float*)d_in[8]; a.conv_w = (const float*)d_in[9]; a.conv_b = (const float*)d_in[10];
    a.conv_ln_g = (const float*)d_in[11]; a.conv_ln_b = (const float*)d_in[12]; a.w_o = (const float*)d_in[13]; a.g_mix_post = (const float*)d_in[14];
    a.g_ffn_pre = (const float*)d_in[15]; a.w_gate = (const float*)d_in[16]; a.w_up = (const float*)d_in[17]; a.dw_w = (const float*)d_in[18];
    a.dw_b = (const float*)d_in[19]; a.w_down = (const float*)d_in[20]; a.g_ffn_post = (const float*)d_in[21]; a.w_ple_proj = (const float*)d_in[22];
    a.g_ple = (const float*)d_in[23]; a.w_ple_gate = (const float*)d_in[24];
    a.out = (float*)d_out; a.ws = (unsigned char*)d_ws;
#if N_LAUNCHES == 1
    a.ph_lo = 0; a.ph_hi = NPHASE;
    void* args[] = {&a};
    hipError_t e = hipLaunchCooperativeKernel((const void*)hymba_fwd, dim3(grid), dim3(512), args, LDS_BYTES, stream);
    if (e != hipSuccess) fprintf(stderr, "kernel_launch: cooperative launch failed: %s (grid %d)\n", hipGetErrorString(e), grid);
#else
    for (int ph = 0; ph < NPHASE; ++ph) for (int rep = 0; rep <= (((REP_MASK) >> ph) & 1); ++rep) {
        a.ph_lo = ph; a.ph_hi = ph + 1;
        hipLaunchKernelGGL(hymba_fwd, dim3(grid), dim3(512), LDS_BYTES, stream, a);
    }
#endif
}
```

```cpp
#include <hip/hip_runtime.h>
#include <hip/hip_cooperative_groups.h>
#include <cstdio>
#include <cstdint>
#include <cmath>
namespace cg = cooperative_groups;
namespace pg8 {
#define PG8_LAS __attribute__((address_space(3)))
typedef unsigned short bf16_t;
typedef short bf16x8 __attribute__((ext_vector_type(8)));
typedef float f32x4 __attribute__((ext_vector_type(4)));
typedef unsigned u32x4 __attribute__((ext_vector_type(4)));
constexpr int BM = 256, BK = 64, HALF = 128, HTB = HALF * BK * 2  , STAGE_BYTES = 8 * HTB, NXCD = 8, WGM = 8;

__host__ __device__ __forceinline__ int lds_byte(int r, int c) { const int st = (r >> 4) * 2 + (c >> 5), rr = r & 15, cc = c & 31, ob = rr * 64 + cc * 2; return st * 1024 + (ob ^ (((ob >> 9) & 1) << 5)); }
__host__ __device__ __forceinline__ void stage_rc(int b, int& R, int& C) { const int st = b / 1024, sb = b % 1024, swz = sb ^ (((sb >> 9) & 1) << 5); R = (st >> 1) * 16 + swz / 64; C = (st & 1) * 32 + (swz % 64) / 2; }
__host__ __device__ __forceinline__ int perm32(int rho) { const int n = rho >> 4, i = rho & 15; return 8 * (i >> 2) + 4 * n + (i & 3); }

struct Unit { int pm, pn; };
struct Gemm { const bf16_t* A; const bf16_t* Bt; int M, N, K; };

struct StaticOrder {
    int nM, nN, nwg, G, c;
    __host__ __device__ void init(int M, int N, int G_, int c_) { nM = M / BM; nN = N / BM; nwg = nM * nN; G = G_; c = c_; }
    __host__ __device__ bool next(int i, Unit& u) const {
        const int L = i * G + c; if (L >= nwg) return false;
        int wgid = L; { const int q = nwg / NXCD, r = nwg % NXCD, xcd = wgid % NXCD, off = wgid / NXCD; wgid = (xcd < r ? xcd * (q + 1) : r * (q + 1) + (xcd - r) * q) + off; }
        const int nig = WGM * nN, gid = wgid / nig, fm = gid * WGM, gsz = (nM - fm) < WGM ? (nM - fm) : WGM;
        u.pm = fm + ((wgid % nig) % gsz); u.pn = (wgid % nig) / gsz; return true;
    }
    __device__ __forceinline__ void a_ready(const Unit&) const {}
    __device__ __forceinline__ void done(const Unit&) const {}
};
__device__ __forceinline__ unsigned cvt_pk_bf16(float lo, float hi) { unsigned r; asm volatile("v_cvt_pk_bf16_f32 %0, %1, %2" : "=v"(r) : "v"(lo), "v"(hi)); return r; }
template <class Epi, class Sched, bool ALIGN_EPI = false, bool SP2 = false>
__device__ __forceinline__ void gemm_phase(PG8_LAS unsigned char* lds, const Gemm g, const Sched& S, const Epi& E) {
    const int tid = threadIdx.x, wid = __builtin_amdgcn_readfirstlane(tid >> 6), lane = tid & 63, wr = wid >> 2, wc = wid & 3, fr = lane & 15, fq = lane >> 4;
    const int K = g.K, nt = K / BK;
    unsigned voffA[2], voffB[2];
#pragma unroll
    for (int i = 0; i < 2; ++i) { int R, C; stage_rc(tid * 16 + i * 8192, R, C); const int Rb = Epi::PERM ? ((R & ~31) + perm32(R & 31)) : R;
        voffA[i] = (unsigned)(R * K + C) * 2u; voffB[i] = (unsigned)(Rb * K + C) * 2u; }
    const size_t kstep = (size_t)(BK * 2);
    const size_t hstep = (size_t)HALF * K * 2;
    const size_t tstep = 2 * hstep;
    const unsigned ldsw = (unsigned)wid * 1024u;
    const int aoff = lds_byte(wr * 64 + fr, fq * 8), boff = lds_byte(wc * 32 + fr, fq * 8);
#define PG8_SA(b, h) (((b) * 2 + (h)) * HTB)
#define PG8_SB(b, h) ((4 + (b) * 2 + (h)) * HTB)
#define PG8_STAGE(bufoff, gbase, voff) do { _Pragma("unroll") for (int _i = 0; _i < 2; ++_i) \
        __builtin_amdgcn_global_load_lds((const unsigned*)((const char*)(gbase) + (voff)[_i]), (PG8_LAS unsigned*)(lds + (bufoff) + ldsw + _i * 8192), 16, 0, 0); } while (0)
#define PG8_LDA(dst, b, h) do { _Pragma("unroll") for (int m = 0; m < 4; ++m) _Pragma("unroll") for (int k = 0; k < 2; ++k) dst[m][k] = *(const PG8_LAS bf16x8*)(lds + PG8_SA(b, h) + aoff + m * 2048 + k * 1024); } while (0)
#define PG8_LDB(dst, b, h) do { _Pragma("unroll") for (int n = 0; n < 2; ++n) _Pragma("unroll") for (int k = 0; k < 2; ++k) dst[n][k] = *(const PG8_LAS bf16x8*)(lds + PG8_SB(b, h) + boff + n * 2048 + k * 1024); } while (0)
#define PG8_MMA(ai, bj, At, Bt) do { __builtin_amdgcn_s_setprio(1); _Pragma("unroll") for (int m = 0; m < 4; ++m) _Pragma("unroll") for (int n = 0; n < 2; ++n) _Pragma("unroll") for (int k = 0; k < 2; ++k) \
        acc[ai][bj][m][n] = __builtin_amdgcn_mfma_f32_16x16x32_bf16(Bt[n][k], At[m][k], acc[ai][bj][m][n], 0, 0, 0); __builtin_amdgcn_s_setprio(0); } while (0)
#define PG8_WAIT_V(n) asm volatile("s_waitcnt vmcnt(" #n ")" ::: "memory")
#define PG8_WAIT_L(n) asm volatile("s_waitcnt lgkmcnt(" #n ")" ::: "memory")
#define PG8_BAR __builtin_amdgcn_s_barrier()
#define PG8_SCHED __builtin_amdgcn_sched_barrier(0)
    Unit cur, nxt; int ui = 0;
    if (!S.next(0, cur)) return;
    f32x4 acc[2][2][4][2];
#pragma unroll
    for (int a = 0; a < 2; ++a)
#pragma unroll
        for (int b = 0; b < 2; ++b)
#pragma unroll
            for (int m = 0; m < 4; ++m)
#pragma unroll
                for (int n = 0; n < 2; ++n) acc[a][b][m][n] = (f32x4){0.f, 0.f, 0.f, 0.f};
    bf16x8 At[4][2], B0[2][2], B1[2][2];
    const char* cA = (const char*)g.A + (size_t)cur.pm * tstep; const char* cB = (const char*)g.Bt + (size_t)cur.pn * tstep;
    S.a_ready(cur);
    if constexpr (SP2) {
        PG8_STAGE(PG8_SB(0, 0), cB, voffB); PG8_STAGE(PG8_SB(0, 1), cB + hstep, voffB); PG8_STAGE(PG8_SA(0, 0), cA, voffA); PG8_STAGE(PG8_SA(0, 1), cA + hstep, voffA);
        if (wr == 1) PG8_BAR;
        PG8_WAIT_V(2); PG8_BAR;
        PG8_STAGE(PG8_SB(1, 0), cB + kstep, voffB); PG8_STAGE(PG8_SA(1, 0), cA + kstep, voffA); PG8_STAGE(PG8_SB(1, 1), cB + hstep + kstep, voffB);
        PG8_WAIT_V(6); PG8_BAR;
    } else {
        PG8_STAGE(PG8_SB(0, 0), cB, voffB); PG8_STAGE(PG8_SA(0, 0), cA, voffA); PG8_STAGE(PG8_SB(0, 1), cB + hstep, voffB); PG8_STAGE(PG8_SA(0, 1), cA + hstep, voffA);
        if (wr == 1) PG8_BAR;
        PG8_WAIT_V(4); PG8_BAR;
        PG8_STAGE(PG8_SB(1, 0), cB + kstep, voffB); PG8_STAGE(PG8_SA(1, 0), cA + kstep, voffA); PG8_STAGE(PG8_SB(1, 1), cB + hstep + kstep, voffB);
        PG8_WAIT_V(6); PG8_BAR;
    }
    for (;;) {
        const bool has_next = S.next(ui + 1, nxt);
        const char* nA = has_next ? (const char*)g.A + (size_t)nxt.pm * tstep : cA; const char* nB = has_next ? (const char*)g.Bt + (size_t)nxt.pn * tstep : cB;
        for (int t = 0; t < nt; t += 2) {
            const bool last = (t == nt - 2);
            const char* a1 = cA + (size_t)(t + 1) * kstep;
            const char* a2 = last ? nA : cA + (size_t)(t + 2) * kstep; const char* b2 = last ? nB : cB + (size_t)(t + 2) * kstep;
            const char* a3 = a2 + kstep; const char* b3 = b2 + kstep;
            if (last && has_next) S.a_ready(nxt);
            if constexpr (SP2) {
            PG8_LDB(B0, 0, 0); PG8_LDB(B1, 0, 1); PG8_SCHED; PG8_LDA(At, 0, 0); PG8_STAGE(PG8_SA(1, 1), a1 + hstep, voffA);
            PG8_WAIT_V(8); PG8_WAIT_L(0); PG8_BAR; PG8_MMA(0, 0, At, B0); PG8_MMA(0, 1, At, B1); PG8_BAR; PG8_SCHED;
            PG8_LDA(At, 0, 1); PG8_STAGE(PG8_SB(0, 0), b2, voffB); PG8_STAGE(PG8_SB(0, 1), b2 + hstep, voffB); PG8_STAGE(PG8_SA(0, 0), a2, voffA);
            PG8_WAIT_V(8); PG8_WAIT_L(0); PG8_BAR; PG8_MMA(1, 0, At, B0); PG8_MMA(1, 1, At, B1); PG8_BAR; PG8_SCHED;
            PG8_LDB(B0, 1, 0); PG8_LDB(B1, 1, 1); PG8_SCHED; PG8_LDA(At, 1, 0); PG8_STAGE(PG8_SA(0, 1), a2 + hstep, voffA);
            PG8_WAIT_V(8); PG8_WAIT_L(0); PG8_BAR; PG8_MMA(0, 0, At, B0); PG8_MMA(0, 1, At, B1); PG8_BAR; PG8_SCHED;
            PG8_LDA(At, 1, 1); PG8_STAGE(PG8_SB(1, 0), b3, voffB); PG8_STAGE(PG8_SB(1, 1), b3 + hstep, voffB); PG8_STAGE(PG8_SA(1, 0), a3, voffA);
            PG8_WAIT_V(8); PG8_WAIT_L(0); PG8_BAR; PG8_MMA(1, 0, At, B0); PG8_MMA(1, 1, At, B1); PG8_BAR; PG8_SCHED;
            } else {
            PG8_LDB(B0, 0, 0); PG8_SCHED; PG8_LDA(At, 0, 0); PG8_STAGE(PG8_SA(1, 1), a1 + hstep, voffA);
            PG8_WAIT_L(8); PG8_BAR; PG8_WAIT_L(0); PG8_MMA(0, 0, At, B0); PG8_BAR; PG8_SCHED;
            PG8_LDB(B1, 0, 1); PG8_STAGE(PG8_SB(0, 0), b2, voffB);
            PG8_BAR; PG8_WAIT_L(0); PG8_MMA(0, 1, At, B1); PG8_BAR;
            PG8_LDA(At, 0, 1); PG8_STAGE(PG8_SA(0, 0), a2, voffA);
            PG8_BAR; PG8_WAIT_L(0); PG8_MMA(1, 0, At, B0); PG8_BAR; PG8_SCHED;
            PG8_STAGE(PG8_SB(0, 1), b2 + hstep, voffB);
            PG8_WAIT_V(6); PG8_BAR; PG8_MMA(1, 1, At, B1); PG8_BAR;
            PG8_LDB(B0, 1, 0); PG8_SCHED; PG8_LDA(At, 1, 0); PG8_STAGE(PG8_SA(0, 1), a2 + hstep, voffA);
            PG8_WAIT_L(8); PG8_BAR; PG8_WAIT_L(0); PG8_MMA(0, 0, At, B0); PG8_BAR; PG8_SCHED;
            PG8_LDB(B1, 1, 1); PG8_STAGE(PG8_SB(1, 0), b3, voffB);
            PG8_BAR; PG8_WAIT_L(0); PG8_MMA(0, 1, At, B1); PG8_BAR;
            PG8_LDA(At, 1, 1); PG8_STAGE(PG8_SA(1, 0), a3, voffA);
            PG8_BAR; PG8_WAIT_L(0); PG8_MMA(1, 0, At, B0); PG8_BAR; PG8_SCHED;
            PG8_STAGE(PG8_SB(1, 1), b3 + hstep, voffB);
            PG8_WAIT_V(6); PG8_BAR; PG8_MMA(1, 1, At, B1); PG8_BAR;
            }
        }
        if constexpr (ALIGN_EPI) { if (wr == 0) PG8_BAR; }
        if constexpr (!Epi::AFTER_DRAIN) { E(acc, cur, wr, wc, fr, fq); S.done(cur); }
        if (!has_next) break;
#pragma unroll
        for (int a = 0; a < 2; ++a)
#pragma unroll
            for (int b = 0; b < 2; ++b)
#pragma unroll
                for (int m = 0; m < 4; ++m)
#pragma unroll
                    for (int n = 0; n < 2; ++n) acc[a][b][m][n] = (f32x4){0.f, 0.f, 0.f, 0.f};
        cur = nxt; cA = nA; cB = nB; ++ui;
        if constexpr (ALIGN_EPI) { if (wr == 1) PG8_BAR; }
    }
    PG8_WAIT_V(0);
    if constexpr (!ALIGN_EPI) { if (wr == 0) PG8_BAR; }
    PG8_BAR;
    if constexpr (Epi::AFTER_DRAIN) { E.fused(acc, cur, wr, wc, fr, fq, lds, wid, lane); S.done(cur); }
#undef PG8_SA
#undef PG8_SB
#undef PG8_STAGE
#undef PG8_LDA
#undef PG8_LDB
#undef PG8_MMA
#undef PG8_WAIT_V
#undef PG8_WAIT_L
#undef PG8_BAR
#undef PG8_SCHED
}
}

using pg8::bf16_t; using pg8::f32x4; using pg8::u32x4; using pg8::Unit;
typedef short bf16x8 __attribute__((ext_vector_type(8)));
typedef float f32x16 __attribute__((ext_vector_type(16)));
typedef unsigned u32x2 __attribute__((ext_vector_type(2)));
#define LAS __attribute__((address_space(3)))

constexpr int TT = 32768, SEQ = 4096, DM = 1024, NPROJ = 1696, NPROJ_P = 1792, PROJ_LD = 768, QL = 384, KVL = 256, NQ = 768, DFF = 2816, PLE = 256;
constexpr int NHEAD = 8, CONVC = 512, CONVW = 31;
constexpr float EPS = 1e-6f;
constexpr float QSCALE = 0.10206207261596575f * 1.4426950408889634f;
constexpr size_t MiB = 1u << 20;
constexpr size_t WS_WIN = 1 * MiB, WS_WQ = 5 * MiB, WS_WK = 6 * MiB, WS_WV = 6 * MiB + 512 * 1024, WS_WO = 7 * MiB, WS_WG = 9 * MiB, WS_WU = 15 * MiB,
                 WS_WD = 21 * MiB, WS_WPP = 27 * MiB, WS_WPG = 28 * MiB, WS_CS = 30 * MiB, WS_RSTD = 34 * MiB, WS_CTL = 35 * MiB, WS_SLOT = 36 * MiB;
constexpr size_t CTL_BYTES = 4 * 128 * 256, BAR_BYTES = 16384, WS_BAR = WS_CTL + 4 * 128 * 256, FLAG_BYTES = 16384, WS_FLAG = WS_BAR + 16384, ROWSS_BYTES = 131072, WS_ROWSS = WS_FLAG + 16384, SLOT_BANK = (size_t)128 * 256 * 4 * 4;
constexpr size_t WS_XB = 40 * MiB, WS_PBF = 104 * MiB, WS_PROJ = 120 * MiB, WS_QAN = 232 * MiB, WS_KVAN = 256 * MiB, WS_CAT = 272 * MiB,
                 WS_GLU = 168 * MiB, WS_K = 336 * MiB, WS_Q = 120 * MiB, WS_VT = 168 * MiB, WS_ACT = 120 * MiB, WS_HALO = 296 * MiB, WS_H1B = 336 * MiB, WS_PE = 400 * MiB, WS_END = 472 * MiB;
constexpr int LDS_BYTES = 147456;
constexpr int NPHASE = 9;

struct Params {
    const float* x; const float* p; const int* pos;
    const float *g_mix_pre, *w_in, *g_q_a, *w_q_b, *g_kv_a, *w_kv_b, *conv_w, *conv_b, *conv_ln_g, *conv_ln_b, *w_o, *g_mix_post, *g_ffn_pre,
                *w_gate, *w_up, *dw_w, *dw_b, *w_down, *g_ffn_post, *w_ple_proj, *g_ple, *w_ple_gate;
    float* out; unsigned char* ws; int ph_lo, ph_hi;
};

__device__ __forceinline__ float bf_lo(unsigned w) { return __uint_as_float(w << 16); }
__device__ __forceinline__ float bf_hi(unsigned w) { return __uint_as_float(w & 0xffff0000u); }
__device__ __forceinline__ float bf1(bf16_t h) { return __uint_as_float((unsigned)h << 16); }
__device__ __forceinline__ unsigned pk2(float lo, float hi) { return pg8::cvt_pk_bf16(lo, hi); }
__device__ __forceinline__ float wave_sum(float v) {
#define WS_DPP(ctrl, rmask) v += __int_as_float(__builtin_amdgcn_update_dpp(0, __float_as_int(v), (ctrl), (rmask), 0xf, true))
    WS_DPP(0x111, 0xf); WS_DPP(0x112, 0xf); WS_DPP(0x114, 0xf); WS_DPP(0x118, 0xf);
    WS_DPP(0x142, 0xa);
    WS_DPP(0x143, 0xc);
#undef WS_DPP
    return __int_as_float(__builtin_amdgcn_readlane(__float_as_int(v), 63));
}
__device__ __forceinline__ float fast_sigmoid(float x) { return __builtin_amdgcn_rcpf(1.0f + __builtin_amdgcn_exp2f(-1.4426950408889634f * x)); }
__device__ __forceinline__ float gelu_tanh(float g) {
    const float u = 0.7978845608028654f * (g + 0.044715f * g * g * g);
    return g * __builtin_amdgcn_rcpf(1.0f + __builtin_amdgcn_exp2f(-2.0f * 1.4426950408889634f * u));
}
typedef float f32x2 __attribute__((ext_vector_type(2)));
__device__ __forceinline__ f32x2 fast_sigmoid2(f32x2 x) { const f32x2 z = x * (-1.4426950408889634f); f32x2 e; e.x = __builtin_amdgcn_exp2f(z.x); e.y = __builtin_amdgcn_exp2f(z.y);
    const f32x2 d = e + 1.0f; f32x2 r; r.x = __builtin_amdgcn_rcpf(d.x); r.y = __builtin_amdgcn_rcpf(d.y); return r; }
__device__ __forceinline__ f32x2 gelu_tanh2(f32x2 g) { const f32x2 t = (g * g) * 0.044715f + 1.0f; const f32x2 z = (g * t) * (-2.0f * 0.7978845608028654f * 1.4426950408889634f);
    f32x2 e; e.x = __builtin_amdgcn_exp2f(z.x); e.y = __builtin_amdgcn_exp2f(z.y); const f32x2 d = e + 1.0f; f32x2 r; r.x = __builtin_amdgcn_rcpf(d.x); r.y = __builtin_amdgcn_rcpf(d.y); return g * r; }
__device__ __forceinline__ void unpack8(const u32x4 w, float (&f)[8]) {
    f[0] = bf_lo(w.x); f[1] = bf_hi(w.x); f[2] = bf_lo(w.y); f[3] = bf_hi(w.y); f[4] = bf_lo(w.z); f[5] = bf_hi(w.z); f[6] = bf_lo(w.w); f[7] = bf_hi(w.w);
}
__device__ __forceinline__ u32x4 pack8(const float (&f)[8]) { u32x4 w; w.x = pk2(f[0], f[1]); w.y = pk2(f[2], f[3]); w.z = pk2(f[4], f[5]); w.w = pk2(f[6], f[7]); return w; }

struct EpiStore {
    static constexpr bool PERM = true, AFTER_DRAIN = false;
    bf16_t* O; long ldc; int lg; long S;
    __device__ __forceinline__ void operator()(const f32x4 (&acc)[2][2][4][2], const Unit& u, int wr, int wc, int fr, int fq) const {
        const int row0 = u.pm * 256 + wr * 64 + fr, c0 = u.pn * 256 + wc * 32 + 8 * fq;
#pragma unroll
        for (int bj = 0; bj < 2; ++bj) { const int c = c0 + bj * 128; const long dcol = (long)(c >> lg) * S + (c & ((1 << lg) - 1));
#pragma unroll
            for (int ai = 0; ai < 2; ++ai)
#pragma unroll
                for (int m = 0; m < 4; ++m) { const f32x4 v0 = acc[ai][bj][m][0], v1 = acc[ai][bj][m][1]; u32x4 w;
                    w.x = pk2(v0[0], v0[1]); w.y = pk2(v0[2], v0[3]); w.z = pk2(v1[0], v1[1]); w.w = pk2(v1[2], v1[3]);
                    *(u32x4*)(O + (long)(row0 + ai * 128 + m * 16) * ldc + dcol) = w; } }
    }
};
struct EpiProj {
    static constexpr bool PERM = true, AFTER_DRAIN = false;
    bf16_t* proj; bf16_t* glu;
    __device__ __forceinline__ void operator()(const f32x4 (&acc)[2][2][4][2], const Unit& u, int wr, int wc, int fr, int fq) const {
        const int row0 = u.pm * 256 + wr * 64 + fr, lc = wc * 32 + 8 * fq;
        if (u.pn < 3) {
#pragma unroll
            for (int bj = 0; bj < 2; ++bj)
#pragma unroll
                for (int ai = 0; ai < 2; ++ai)
#pragma unroll
                    for (int m = 0; m < 4; ++m) { const f32x4 v0 = acc[ai][bj][m][0], v1 = acc[ai][bj][m][1]; u32x4 w;
                        w.x = pk2(v0[0], v0[1]); w.y = pk2(v0[2], v0[3]); w.z = pk2(v1[0], v1[1]); w.w = pk2(v1[2], v1[3]);
                        *(u32x4*)(proj + (long)(row0 + ai * 128 + m * 16) * PROJ_LD + u.pn * 256 + bj * 128 + lc) = w; }
        } else {
#pragma unroll
            for (int ai = 0; ai < 2; ++ai)
#pragma unroll
                for (int m = 0; m < 4; ++m) { float o[8];
#pragma unroll
                    for (int e = 0; e < 8; e += 2) { const f32x2 a = {acc[ai][0][m][e >> 2][e & 3], acc[ai][0][m][(e + 1) >> 2][(e + 1) & 3]}, gt = {acc[ai][1][m][e >> 2][e & 3], acc[ai][1][m][(e + 1) >> 2][(e + 1) & 3]};
                        const f32x2 r = a * fast_sigmoid2(gt); o[e] = r.x; o[e + 1] = r.y; }
                    *(u32x4*)(glu + (long)(row0 + ai * 128 + m * 16) * CONVC + (u.pn - 3) * 128 + lc) = pack8(o); }
        }
    }
};
__device__ __forceinline__ float dpp_shr1(float old, float src) { return __int_as_float(__builtin_amdgcn_update_dpp(__float_as_int(old), __float_as_int(src), 0x111, 0xf, 0xf, false)); }
__device__ __forceinline__ float dpp_shr2(float old, float src) { return __int_as_float(__builtin_amdgcn_update_dpp(__float_as_int(old), __float_as_int(src), 0x112, 0xf, 0xf, false)); }
__device__ __forceinline__ float dpp_ror1(float src) { return __int_as_float(__builtin_amdgcn_update_dpp(0, __float_as_int(src), 0x121, 0xf, 0xf, false)); }
__device__ __forceinline__ float dpp_ror2(float src) { return __int_as_float(__builtin_amdgcn_update_dpp(0, __float_as_int(src), 0x122, 0xf, 0xf, false)); }
struct EpiGU {
    static constexpr bool PERM = true, AFTER_DRAIN = false;
    bf16_t* act; const float* dw; const float* db; float* halo; unsigned* flag; PG8_LAS float* E;
    template <int AI, int M>
    __device__ __forceinline__ void rows16(const f32x4 (&acc)[2][2][4][2], const float (&P1)[8], const float (&P2)[8], const float (&w0)[8], const float (&w1)[8], const float (&w2)[8], const float (&bb)[8],
                                           long row, int c, int fr) const {
        float o[8];
#pragma unroll
        for (int e = 0; e < 8; e += 2) { f32x2 g, g1, g2;
#pragma unroll
            for (int k = 0; k < 2; ++k) { const int ee = e + k; const float gv = acc[AI][0][M][ee >> 2][ee & 3];
                float s1, s2;
                if (M > 0) { const float pv = acc[AI][0][M > 0 ? M - 1 : 0][ee >> 2][ee & 3]; s1 = dpp_ror1(pv); s2 = dpp_ror2(pv); }
                else { s1 = P1[ee]; s2 = fr == 0 ? P2[ee] : P1[ee]; }
                g[k] = gv; g1[k] = dpp_shr1(s1, gv); g2[k] = dpp_shr2(s2, gv); }
            const f32x2 w0v = {w0[e], w0[e + 1]}, w1v = {w1[e], w1[e + 1]}, w2v = {w2[e], w2[e + 1]}, bv = {bb[e], bb[e + 1]};
            const f32x2 upv = {acc[AI][1][M][e >> 2][e & 3], acc[AI][1][M][(e + 1) >> 2][(e + 1) & 3]};
            const f32x2 cv = bv + w0v * g2 + w1v * g1 + w2v * g;
            const f32x2 ov = gelu_tanh2(cv) * upv; o[e] = ov.x; o[e + 1] = ov.y; }
        *(u32x4*)(act + row * DFF + c) = pack8(o);
    }
    __device__ __forceinline__ void operator()(const f32x4 (&acc)[2][2][4][2], const Unit& u, int wr, int wc, int fr, int fq) const {
        const int lc = wc * 32 + 8 * fq;
        const int c = u.pn * 128 + lc;
        if (fr >= 14) {
#pragma unroll
            for (int ai = 0; ai < 2; ++ai)
#pragma unroll
                for (int n = 0; n < 2; ++n) *(PG8_LAS f32x4*)(E + ((ai * 2 + wr) * 2 + (fr - 14)) * 128 + lc + 4 * n) = acc[ai][0][3][n];
            if (wr == 1) { float* hp = halo + ((size_t)(u.pm * 22 + u.pn) * 2 + (fr - 14)) * 128 + lc;
#pragma unroll
                for (int n = 0; n < 2; ++n)
#pragma unroll
                    for (int e = 0; e < 4; ++e) __hip_atomic_store(hp + 4 * n + e, acc[1][0][3][n][e], __ATOMIC_RELAXED, __HIP_MEMORY_SCOPE_AGENT); }
        }
        if (wr == 1) { asm volatile("s_waitcnt vmcnt(0)" ::: "memory");
            if ((fr | fq) == 0) __hip_atomic_fetch_add(flag + u.pm * 22 + u.pn, 1u, __ATOMIC_RELAXED, __HIP_MEMORY_SCOPE_AGENT); }
        float w0[8], w1[8], w2[8], bb[8];
#pragma unroll
        for (int e = 0; e < 8; ++e) { w0[e] = dw[c + e]; w1[e] = dw[DFF + c + e]; w2[e] = dw[2 * DFF + c + e]; bb[e] = db[c + e]; }
        const long rb = (long)u.pm * 256 + wr * 64 + fr;
        const float Z[8] = {0.f, 0.f, 0.f, 0.f, 0.f, 0.f, 0.f, 0.f};
        rows16<1, 1>(acc, Z, Z, w0, w1, w2, bb, rb + 128 + 16, c, fr); rows16<1, 2>(acc, Z, Z, w0, w1, w2, bb, rb + 128 + 32, c, fr); rows16<1, 3>(acc, Z, Z, w0, w1, w2, bb, rb + 128 + 48, c, fr);
        rows16<0, 1>(acc, Z, Z, w0, w1, w2, bb, rb + 16, c, fr); rows16<0, 2>(acc, Z, Z, w0, w1, w2, bb, rb + 32, c, fr); rows16<0, 3>(acc, Z, Z, w0, w1, w2, bb, rb + 48, c, fr);
        asm volatile("s_waitcnt lgkmcnt(0)" ::: "memory"); __builtin_amdgcn_s_barrier(); asm volatile("" ::: "memory");
        { float P1[8], P2[8]; const int blk = 2 + wr;
#pragma unroll
          for (int n = 0; n < 2; ++n) { const f32x4 a = *(const PG8_LAS f32x4*)(E + ((blk - 1) * 2 + 1) * 128 + lc + 4 * n), d = *(const PG8_LAS f32x4*)(E + ((blk - 1) * 2 + 0) * 128 + lc + 4 * n);
#pragma unroll
              for (int e = 0; e < 4; ++e) { P1[4 * n + e] = a[e]; P2[4 * n + e] = d[e]; } }
          rows16<1, 0>(acc, P1, P2, w0, w1, w2, bb, rb + 128, c, fr); }
        { float P1[8], P2[8];
          const bool need_halo = (wr == 0) && ((u.pm & 15) != 0);
          if (wr == 1) {
#pragma unroll
              for (int n = 0; n < 2; ++n) { const f32x4 a = *(const PG8_LAS f32x4*)(E + 1 * 128 + lc + 4 * n), d = *(const PG8_LAS f32x4*)(E + lc + 4 * n);
#pragma unroll
                  for (int e = 0; e < 4; ++e) { P1[4 * n + e] = a[e]; P2[4 * n + e] = d[e]; } }
          } else if (need_halo) { unsigned* fp = flag + (u.pm - 1) * 22 + u.pn; unsigned spins = 0;
              while ((unsigned)__builtin_amdgcn_readfirstlane(__hip_atomic_load(fp, __ATOMIC_RELAXED, __HIP_MEMORY_SCOPE_AGENT)) < 4u) { if (++spins > (1u << 22)) break; __builtin_amdgcn_s_sleep(1); }
              const float* hp = halo + ((size_t)((u.pm - 1) * 22 + u.pn) * 2) * 128 + lc;
#pragma unroll
              for (int e = 0; e < 8; ++e) { P1[e] = __hip_atomic_load(hp + 128 + e, __ATOMIC_RELAXED, __HIP_MEMORY_SCOPE_AGENT); P2[e] = __hip_atomic_load(hp + e, __ATOMIC_RELAXED, __HIP_MEMORY_SCOPE_AGENT); }
          } else {
#pragma unroll
              for (int e = 0; e < 8; ++e) { P1[e] = 0.f; P2[e] = 0.f; }
          }
          rows16<0, 0>(acc, P1, P2, w0, w1, w2, bb, rb, c, fr); }
    }
};
struct PanelSumsq {
    float* xbuf; unsigned* cnt; int panel0; float eps;
    __device__ __forceinline__ void run(const f32x4 (&v)[2][2][4][2], const Unit& u, int wr, int wc, int fr, int fq, PG8_LAS unsigned char* lds, int wid, int lane) const {
        publish(v, u, wr, wc, fr, fq, lds, wid, lane); finish(u, lds, wid, lane);
    }
    __device__ __forceinline__ void publish(const f32x4 (&v)[2][2][4][2], const Unit& u, int wr, int wc, int fr, int fq, PG8_LAS unsigned char* lds, int wid, int lane) const {
        PG8_LAS float* Pp = (PG8_LAS float*)lds;
#pragma unroll
        for (int ai = 0; ai < 2; ++ai)
#pragma unroll
            for (int m = 0; m < 4; ++m) { float q = 0.f;
#pragma unroll
                for (int bj = 0; bj < 2; ++bj)
#pragma unroll
                    for (int n = 0; n < 2; ++n) { const f32x4 x = v[ai][bj][m][n]; q += (x[0] * x[0] + x[1] * x[1]) + (x[2] * x[2] + x[3] * x[3]); }
                q += __shfl_xor(q, 16); q += __shfl_xor(q, 32);
                if (fq == 0) Pp[(ai * 128 + wr * 64 + m * 16 + fr) * 4 + wc] = q; }
        asm volatile("s_waitcnt lgkmcnt(0)" ::: "memory"); __builtin_amdgcn_s_barrier(); asm volatile("" ::: "memory");
        const int row = wid * 32 + (lane & 31); const int panel = panel0 + u.pm;
        if (lane < 32) { const float tot = (Pp[row * 4 + 0] + Pp[row * 4 + 1]) + (Pp[row * 4 + 2] + Pp[row * 4 + 3]);
            __hip_atomic_store(xbuf + ((size_t)(panel * 256 + row) * 4 + u.pn), tot, __ATOMIC_RELAXED, __HIP_MEMORY_SCOPE_AGENT); }
        asm volatile("s_waitcnt vmcnt(0)" ::: "memory");
        if (lane == 0) __hip_atomic_fetch_add(cnt + 64 * panel, 1u, __ATOMIC_RELAXED, __HIP_MEMORY_SCOPE_AGENT);
    }
    __device__ __forceinline__ void finish(const Unit& u, PG8_LAS unsigned char* lds, int wid, int lane) const {
        PG8_LAS float* S = (PG8_LAS float*)(lds + 4096);
        const int row = wid * 32 + (lane & 31); const int panel = panel0 + u.pm;
        if (wid == 0) {
            unsigned spins = 0;
            for (;;) { if ((unsigned)__builtin_amdgcn_readfirstlane(__hip_atomic_load(cnt + 64 * panel, __ATOMIC_RELAXED, __HIP_MEMORY_SCOPE_AGENT)) >= 32u) break;
                if (++spins > (1u << 22)) break;
                __builtin_amdgcn_s_sleep(2); }
            __builtin_amdgcn_fence(__ATOMIC_ACQUIRE, "agent");
        }
        asm volatile("s_waitcnt vmcnt(0) lgkmcnt(0)" ::: "memory"); __builtin_amdgcn_s_barrier(); asm volatile("" ::: "memory");
        if (lane < 32) { const float* slot = xbuf + (size_t)(panel * 256 + row) * 4; float t = 0.f;
#pragma unroll
            for (int k = 0; k < 4; ++k) t += __hip_atomic_load(slot + k, __ATOMIC_RELAXED, __HIP_MEMORY_SCOPE_AGENT);
            S[row] = __builtin_amdgcn_rsqf(t * (1.0f / 1024.0f) + eps); }
        asm volatile("s_waitcnt lgkmcnt(0)" ::: "memory"); __builtin_amdgcn_s_barrier(); asm volatile("" ::: "memory");
    }
};
struct EpiWo {
    static constexpr bool PERM = true, AFTER_DRAIN = false;
    const float* x; bf16_t* h1b; bf16_t* xn; const float* g_post; const float* g_pre; PanelSumsq st1, st2; PG8_LAS unsigned char* lds;
    __device__ __forceinline__ void operator()(f32x4 (&acc)[2][2][4][2], const Unit& u, int wr, int wc, int fr, int fq) const {
        const int wid = wr * 4 + wc, lane = fq * 16 + fr;
        const PG8_LAS float* S = (const PG8_LAS float*)(lds + 4096);
        const int col0 = u.pn * 256 + wc * 32 + 8 * fq;
        st1.publish(acc, u, wr, wc, fr, fq, lds, wid, lane);
        f32x4 X0[3][2][2];
#pragma unroll
        for (int m = 0; m < 3; ++m) { const size_t off = (size_t)(u.pm * 256 + wr * 64 + m * 16 + fr) * DM + col0;
#pragma unroll
            for (int bj = 0; bj < 2; ++bj)
#pragma unroll
                for (int n = 0; n < 2; ++n) X0[m][bj][n] = __builtin_nontemporal_load((const f32x4*)(x + off + bj * 128 + n * 4)); }
        st1.finish(u, lds, wid, lane);
#pragma unroll
        for (int ai = 0; ai < 2; ++ai)
#pragma unroll
            for (int m = 0; m < 4; ++m) { const int r = ai * 128 + wr * 64 + m * 16 + fr; const float rs = S[r]; const size_t off = (size_t)(u.pm * 256 + r) * DM + col0;
#pragma unroll
                for (int bj = 0; bj < 2; ++bj)
#pragma unroll
                    for (int n = 0; n < 2; ++n) { const f32x4 xv = (ai == 0 && m < 3) ? X0[m < 3 ? m : 0][bj][n] : __builtin_nontemporal_load((const f32x4*)(x + off + bj * 128 + n * 4)); const f32x4 g = *(const f32x4*)(g_post + col0 + bj * 128 + n * 4);
                        acc[ai][bj][m][n] = xv + acc[ai][bj][m][n] * rs * g; }
                asm volatile("" : "+v"(acc[ai][0][m][0]), "+v"(acc[ai][0][m][1]), "+v"(acc[ai][1][m][0]), "+v"(acc[ai][1][m][1]));
                if (m & 1) asm volatile("" ::: "memory"); }
        st2.publish(acc, u, wr, wc, fr, fq, lds, wid, lane);
#pragma unroll
        for (int ai = 0; ai < 2; ++ai)
#pragma unroll
            for (int m = 0; m < 4; ++m) { const size_t off = (size_t)(u.pm * 256 + ai * 128 + wr * 64 + m * 16 + fr) * DM + col0;
#pragma unroll
                for (int bj = 0; bj < 2; ++bj) { const f32x4 h0 = acc[ai][bj][m][0], h1 = acc[ai][bj][m][1];
                    u32x4 hw; hw.x = pk2(h0[0], h0[1]); hw.y = pk2(h0[2], h0[3]); hw.z = pk2(h1[0], h1[1]); hw.w = pk2(h1[2], h1[3]); *(u32x4*)(h1b + off + bj * 128) = hw; } }
        st2.finish(u, lds, wid, lane);
#pragma unroll
        for (int ai = 0; ai < 2; ++ai)
#pragma unroll
            for (int m = 0; m < 4; ++m) { const int r = ai * 128 + wr * 64 + m * 16 + fr; const float rs = S[r]; const size_t off = (size_t)(u.pm * 256 + r) * DM + col0;
#pragma unroll
                for (int bj = 0; bj < 2; ++bj) { const f32x4 h0 = acc[ai][bj][m][0], h1 = acc[ai][bj][m][1];
                    const f32x4 g0 = *(const f32x4*)(g_pre + col0 + bj * 128), g1 = *(const f32x4*)(g_pre + col0 + bj * 128 + 4); const f32x4 o0 = h0 * rs * g0, o1 = h1 * rs * g1;
                    u32x4 w; w.x = pk2(o0[0], o0[1]); w.y = pk2(o0[2], o0[3]); w.z = pk2(o1[0], o1[1]); w.w = pk2(o1[2], o1[3]); *(u32x4*)(xn + off + bj * 128) = w; }
                asm volatile("" ::: "memory"); }
    }
};
struct EpiDown {
    static constexpr bool PERM = true, AFTER_DRAIN = false;
    const bf16_t* res; bf16_t* xn; const float* g; PanelSumsq st; PG8_LAS unsigned char* lds;
    __device__ __forceinline__ void operator()(f32x4 (&acc)[2][2][4][2], const Unit& u, int wr, int wc, int fr, int fq) const {
        const int wid = wr * 4 + wc, lane = fq * 16 + fr;
        const PG8_LAS float* S = (const PG8_LAS float*)(lds + 4096);
        const int col0 = u.pn * 256 + wc * 32 + 8 * fq;
        st.publish(acc, u, wr, wc, fr, fq, lds, wid, lane);
        u32x4 R[2][4][2];
#pragma unroll
        for (int ai = 0; ai < 2; ++ai)
#pragma unroll
            for (int m = 0; m < 4; ++m) { const size_t off = (size_t)(u.pm * 256 + ai * 128 + wr * 64 + m * 16 + fr) * DM + col0;
#pragma unroll
                for (int bj = 0; bj < 2; ++bj) R[ai][m][bj] = *(const u32x4*)(res + off + bj * 128); }
        st.finish(u, lds, wid, lane);
#pragma unroll
        for (int ai = 0; ai < 2; ++ai)
#pragma unroll
            for (int m = 0; m < 4; ++m) { const int r = ai * 128 + wr * 64 + m * 16 + fr; const float rs = S[r]; const size_t off = (size_t)(u.pm * 256 + r) * DM + col0;
#pragma unroll
                for (int bj = 0; bj < 2; ++bj) { const f32x4 g0 = *(const f32x4*)(g + col0 + bj * 128), g1 = *(const f32x4*)(g + col0 + bj * 128 + 4);
                    float hv[8]; unpack8(R[ai][m][bj], hv);
                    const f32x4 a0 = acc[ai][bj][m][0] * rs * g0, a1 = acc[ai][bj][m][1] * rs * g1; float o[8];
#pragma unroll
                    for (int e = 0; e < 4; ++e) { o[e] = hv[e] + a0[e]; o[4 + e] = hv[4 + e] + a1[e]; }
                    *(u32x4*)(xn + off + bj * 128) = pack8(o); } }
    }
};
struct EpiPe {
    static constexpr bool PERM = true, AFTER_DRAIN = false;
    bf16_t* O; float* rowss;
    __device__ __forceinline__ void operator()(const f32x4 (&acc)[2][2][4][2], const Unit& u, int wr, int wc, int fr, int fq) const {
        const int row0 = u.pm * 256 + wr * 64 + fr, c0 = u.pn * 256 + wc * 32 + 8 * fq;
#pragma unroll
        for (int ai = 0; ai < 2; ++ai)
#pragma unroll
            for (int m = 0; m < 4; ++m) { const int row = row0 + ai * 128 + m * 16; float q = 0.f;
#pragma unroll
                for (int bj = 0; bj < 2; ++bj) { const f32x4 v0 = acc[ai][bj][m][0], v1 = acc[ai][bj][m][1]; u32x4 w;
                    q += (v0[0] * v0[0] + v0[1] * v0[1]) + (v0[2] * v0[2] + v0[3] * v0[3]) + (v1[0] * v1[0] + v1[1] * v1[1]) + (v1[2] * v1[2] + v1[3] * v1[3]);
                    w.x = pk2(v0[0], v0[1]); w.y = pk2(v0[2], v0[3]); w.z = pk2(v1[0], v1[1]); w.w = pk2(v1[2], v1[3]);
                    *(u32x4*)(O + (long)row * DM + c0 + bj * 128) = w; }
                q += __shfl_xor(q, 16); q += __shfl_xor(q, 32);
                if (fq == 0) atomicAdd(rowss + row, q); }
    }
};
struct EpiOut {
    static constexpr bool PERM = true, AFTER_DRAIN = false;
    float* out; const bf16_t* h2b; const bf16_t* pe; const float* rowss; const float* gple;
    __device__ __forceinline__ void operator()(const f32x4 (&acc)[2][2][4][2], const Unit& u, int wr, int wc, int fr, int fq) const {
        const int row0 = u.pm * 256 + wr * 64 + fr, c0 = u.pn * 256 + wc * 32 + 8 * fq;
#pragma unroll
        for (int bj = 0; bj < 2; ++bj) { const int c = c0 + bj * 128;
            const f32x4 ga = *(const f32x4*)(gple + c), gb = *(const f32x4*)(gple + c + 4);
#pragma unroll
            for (int ai = 0; ai < 2; ++ai) {
            u32x4 H[4], Q[4]; float R[4];
#pragma unroll
            for (int m = 0; m < 4; ++m) { const int row = row0 + ai * 128 + m * 16;
                H[m] = *(const u32x4*)(h2b + (long)row * DM + c); Q[m] = __builtin_nontemporal_load((const u32x4*)(pe + (long)row * DM + c)); R[m] = rowss[row]; }
            __builtin_amdgcn_sched_barrier(0);
#pragma unroll
            for (int m = 0; m < 4; ++m) { const int row = row0 + ai * 128 + m * 16; const float r = __builtin_amdgcn_rsqf(R[m] * (1.0f / DM) + EPS);
                float hv[8], pv[8]; unpack8(H[m], hv); unpack8(Q[m], pv);
                const f32x4 v0 = acc[ai][bj][m][0], v1 = acc[ai][bj][m][1]; f32x4 o0, o1;
#pragma unroll
                for (int e = 0; e < 4; e += 2) { const f32x2 s0 = fast_sigmoid2((f32x2){v0[e], v0[e + 1]}), s1 = fast_sigmoid2((f32x2){v1[e], v1[e + 1]});
                    const f32x2 e0 = (f32x2){pv[e], pv[e + 1]} * r * (f32x2){ga[e], ga[e + 1]}, e1 = (f32x2){pv[4 + e], pv[5 + e]} * r * (f32x2){gb[e], gb[e + 1]};
                    const f32x2 q0 = (f32x2){hv[e], hv[e + 1]} + s0 * e0, q1 = (f32x2){hv[4 + e], hv[5 + e]} + s1 * e1;
                    o0[e] = q0.x; o0[e + 1] = q0.y; o1[e] = q1.x; o1[e + 1] = q1.y; }
                float* op = out + (long)row * DM + c; *(f32x4*)op = o0; *(f32x4*)(op + 4) = o1; } } }
    }
};
template <class Epi>
__device__ __forceinline__ void run_gemm_fused(LAS unsigned char* lds, const bf16_t* A, const bf16_t* Bt, int K, int G, int c, const Epi& E) {
    pg8::Gemm g{A, Bt, 16384, DM, K}; pg8::StaticOrder S; S.init(16384, DM, G, c);
    pg8::gemm_phase<Epi, pg8::StaticOrder, false, true>(lds, g, S, E);
    __syncthreads();
}

template <class Epi>
__device__ __forceinline__ void run_gemm(LAS unsigned char* lds, const bf16_t* A, const bf16_t* Bt, int M, int N, int K, int G, int c, const Epi& E) {
    pg8::Gemm g{A, Bt, M, N, K}; pg8::StaticOrder S; S.init(M, N, G, c);
    pg8::gemm_phase<Epi, pg8::StaticOrder, true, true>(lds, g, S, E);
    __syncthreads();
}

__device__ __forceinline__ int src_col(int mode, int n) {
    if (mode == 1) { const int h = n / 96, w = n % 96; if (w < 64) return n; const int j = w - 64; return h * 96 + 64 + 16 * (j & 1) + (j >> 1); }
    if (mode == 2) return (n >> 6) * 128 + (n & 63);
    if (mode == 3) return (n >> 6) * 128 + 64 + (n & 63);
    if (mode == 4) return (n >> 8) * 128 + (n & 127);
    if (mode == 5) { if (n < 672) return n; if (n < 768) return -1; const int e = n - 768, k = e >> 8, w = e & 255; return 672 + (w >= 128 ? 512 : 0) + 128 * k + (w & 127); }
    return n;
}
__device__ __forceinline__ void transpose_item(const float* W, int K, int Nsrc, int Ndst, bf16_t* WT, LAS float* scr, int item, int lane, int mode, float mul = 1.0f) {
    const int nblk = Ndst / 32, kb = item / nblk, nb = item % nblk, k0 = 64 * kb, n0 = 32 * nb;
    const int sc = src_col(mode, n0 + (lane & 31));
    float tv[32];
#pragma unroll
    for (int i = 0; i < 32; ++i) { const int kk = 2 * i + (lane >> 5); tv[i] = sc >= 0 ? __builtin_nontemporal_load(W + (size_t)(k0 + kk) * Nsrc + sc) : 0.f; }
#pragma unroll
    for (int i = 0; i < 32; ++i) { const int kk = 2 * i + (lane >> 5); scr[kk * 33 + (lane & 31)] = tv[i] * mul; }
    asm volatile("s_waitcnt lgkmcnt(0)" ::: "memory");
    const int c = lane & 7;
#pragma unroll
    for (int j = 0; j < 4; ++j) { const int n = (lane >> 3) + 8 * j; const LAS float* s = scr + (8 * c) * 33 + n;
        u32x4 o; o.x = pk2(s[0 * 33], s[1 * 33]); o.y = pk2(s[2 * 33], s[3 * 33]); o.z = pk2(s[4 * 33], s[5 * 33]); o.w = pk2(s[6 * 33], s[7 * 33]);
        *(u32x4*)(WT + (size_t)(n0 + n) * K + k0 + 8 * c) = o; }
    asm volatile("s_waitcnt lgkmcnt(0)" ::: "memory");
}
__device__ __forceinline__ void load_row_f32(const float* rp, int lane, float (&v)[16]) {
#pragma unroll
    for (int j = 0; j < 2; ++j) { const f32x4 a = *(const f32x4*)(rp + 512 * j + 8 * lane), b = *(const f32x4*)(rp + 512 * j + 8 * lane + 4);
#pragma unroll
        for (int e = 0; e < 4; ++e) { v[8 * j + e] = a[e]; v[8 * j + 4 + e] = b[e]; } }
}
__device__ __forceinline__ void load_row_bf16(const bf16_t* rp, int lane, float (&v)[16]) {
#pragma unroll
    for (int j = 0; j < 2; ++j) { const u32x4 w = *(const u32x4*)(rp + 512 * j + 8 * lane); float f[8]; unpack8(w, f);
#pragma unroll
        for (int e = 0; e < 8; ++e) v[8 * j + e] = f[e]; }
}
__device__ __forceinline__ void store_row_bf16(bf16_t* rp, int lane, const float (&v)[16]) {
#pragma unroll
    for (int j = 0; j < 2; ++j) { float f[8];
#pragma unroll
        for (int e = 0; e < 8; ++e) f[e] = v[8 * j + e];
        *(u32x4*)(rp + 512 * j + 8 * lane) = pack8(f); }
}
__device__ __forceinline__ void store_row_f32(float* rp, int lane, const float (&v)[16]) {
#pragma unroll
    for (int j = 0; j < 2; ++j) { f32x4 a, b;
#pragma unroll
        for (int e = 0; e < 4; ++e) { a[e] = v[8 * j + e]; b[e] = v[8 * j + 4 + e]; }
        *(f32x4*)(rp + 512 * j + 8 * lane) = a; *(f32x4*)(rp + 512 * j + 8 * lane + 4) = b; }
}
__device__ __forceinline__ float sumsq16(const float (&v)[16]) { float s = 0.f;
#pragma unroll
    for (int e = 0; e < 16; ++e) s += v[e] * v[e];
    return s; }

__device__ __forceinline__ void phase_prologue(const Params& P, LAS unsigned char* lds, int vcu, int G, int wave, int lane) {
    unsigned char* ws = P.ws;
    LAS float* scr = (LAS float*)(lds + wave * 16384);
    const int gw = vcu * 8 + wave, NGW = G * 8;
    const int gt = gw * 64 + lane, NGT = NGW * 64;
    const int gw4 = vcu * 4 + (wave & 3), NGW4 = G * 4, gt4 = gw4 * 64 + lane, NGT4 = NGW4 * 64;
    if (wave >= 4) {
    constexpr int I0 = 16 * 56, I1 = 6 * 24, I2 = 4 * 16, I3 = 4 * 16, I4 = 16 * 32, I5 = 16 * 176, I6 = 0, I7 = 44 * 32, I8 = 4 * 32, I9 = 16 * 32;
    constexpr int NITEMS = I0 + I1 + I2 + I3 + I4 + I5 + I6 + I7 + I8 + I9;
    for (int it = gw4; it < NITEMS; it += NGW4) {
        int r = it;
        if (r < I0) { transpose_item(P.w_in, DM, NPROJ, NPROJ_P, (bf16_t*)(ws + WS_WIN), scr, r, lane, 5); continue; } r -= I0;
        if (r < I1) { transpose_item(P.w_q_b, QL, NQ, NQ, (bf16_t*)(ws + WS_WQ), scr, r, lane, 1, QSCALE); continue; } r -= I1;
        if (r < I2) { transpose_item(P.w_kv_b, KVL, 1024, 512, (bf16_t*)(ws + WS_WK), scr, r, lane, 2); continue; } r -= I2;
        if (r < I3) { transpose_item(P.w_kv_b, KVL, 1024, 512, (bf16_t*)(ws + WS_WV), scr, r, lane, 3); continue; } r -= I3;
        if (r < I4) { transpose_item(P.w_o, DM, DM, DM, (bf16_t*)(ws + WS_WO), scr, r, lane, 0); continue; } r -= I4;
        if (r < I5) { const int nb = r % 176; transpose_item((nb & 4) ? P.w_up : P.w_gate, DM, DFF, 2 * DFF, (bf16_t*)(ws + WS_WG), scr, r, lane, 4); continue; } r -= I5;
        if (r < I7) { transpose_item(P.w_down, DFF, DM, DM, (bf16_t*)(ws + WS_WD), scr, r, lane, 0); continue; } r -= I7;
        if (r < I8) { transpose_item(P.w_ple_proj, PLE, DM, DM, (bf16_t*)(ws + WS_WPP), scr, r, lane, 0); continue; } r -= I8;
        transpose_item(P.w_ple_gate, DM, DM, DM, (bf16_t*)(ws + WS_WPG), scr, r, lane, 0);
    }
    { float* cs = (float*)(ws + WS_CS);
      for (int i = gt4; i < TT * 16; i += NGT4) { const int t = i >> 4, k = i & 15;
          const float inv = exp2f(-(float)k * (13.287712379549449f / 16.0f));
          const float ang = (float)P.pos[t] * inv;
          const double rev = (double)ang * 0.15915494309189535; const float fr = (float)(rev - floor(rev));
          cs[2 * (size_t)i] = __builtin_amdgcn_cosf(fr); cs[2 * (size_t)i + 1] = __builtin_amdgcn_sinf(fr); } }
    }
    { constexpr int XN_SPLIT = 27648; const int lo = wave < 4 ? 0 : XN_SPLIT, hi_ = wave < 4 ? XN_SPLIT : TT;
      f32x4 g[4];
#pragma unroll
      for (int j = 0; j < 4; ++j) g[j] = *(const f32x4*)(P.g_mix_pre + 4 * lane + 256 * j);
      bf16_t* XB = (bf16_t*)(ws + WS_XB);
      for (int m = lo + gw4; m < hi_; m += 4 * NGW4) { f32x4 v[4][4];
#pragma unroll
          for (int u = 0; u < 4; ++u) { const int mm = m + u * NGW4 < hi_ ? m + u * NGW4 : m;
#pragma unroll
              for (int j = 0; j < 4; ++j) v[u][j] = __builtin_nontemporal_load((const f32x4*)(P.x + (size_t)mm * DM + 4 * lane + 256 * j)); }
#pragma unroll
          for (int u = 0; u < 4; ++u) { const int mm = m + u * NGW4; float ss = 0.f;
#pragma unroll
              for (int j = 0; j < 4; ++j) ss += (v[u][j][0] * v[u][j][0] + v[u][j][1] * v[u][j][1]) + (v[u][j][2] * v[u][j][2] + v[u][j][3] * v[u][j][3]);
              const float rstd = __builtin_amdgcn_rsqf(wave_sum(ss) * (1.0f / DM) + EPS);
              if (mm < hi_) {
#pragma unroll
                  for (int j = 0; j < 4; ++j) { const f32x4 o = v[u][j] * rstd * g[j]; u32x2 w; w.x = pk2(o[0], o[1]); w.y = pk2(o[2], o[3]);
                      *(u32x2*)(XB + (size_t)mm * DM + 4 * lane + 256 * j) = w; } } } } }
    { const f32x4* pp = (const f32x4*)P.p; u32x2* pb = (u32x2*)(ws + WS_PBF); constexpr int NCH = TT * PLE / 4;
      for (int i = gt; i < NCH; i += 4 * NGT) { f32x4 a[4];
#pragma unroll
          for (int u = 0; u < 4; ++u) a[u] = __builtin_nontemporal_load(pp + (i + u * NGT < NCH ? i + u * NGT : i));
#pragma unroll
          for (int u = 0; u < 4; ++u) if (i + u * NGT < NCH) { u32x2 o; o.x = pk2(a[u][0], a[u][1]); o.y = pk2(a[u][2], a[u][3]); pb[i + u * NGT] = o; } } }
}

__device__ __forceinline__ void phase_r1(const Params& P, LAS unsigned char* lds, int vcu, int G, int tid, int wave, int lane) {
    unsigned char* ws = P.ws;
    const bf16_t* proj = (const bf16_t*)(ws + WS_PROJ);
    bf16_t* qan = (bf16_t*)(ws + WS_QAN); bf16_t* kvan = (bf16_t*)(ws + WS_KVAN); bf16_t* Kb = (bf16_t*)(ws + WS_K); bf16_t* cat = (bf16_t*)(ws + WS_CAT);
    const float* cs = (const float*)(ws + WS_CS);
    LAS float* cbuf = (LAS float*)lds;
    for (int ch = vcu; ch < TT / 128; ch += G) {
        const int t0 = ch * 128;
        { const bool has_halo = (t0 & (SEQ - 1)) != 0;
#define R1_BAR() do { asm volatile("s_waitcnt lgkmcnt(0)" ::: "memory"); __builtin_amdgcn_s_barrier(); asm volatile("" ::: "memory"); } while (0)
          if (wave < 4) {
              const int tc = tid;
              f32x2 w2[CONVW];
              { const float* wp = P.conv_w + 2 * tc;
#pragma unroll
                for (int j = 0; j < CONVW; ++j) { w2[j] = *(const f32x2*)wp; wp += CONVC; asm volatile("" : "+v"(wp)); } }
              const f32x2 bias2 = *(const f32x2*)(P.conv_b + 2 * tc);
              const unsigned* pg = (const unsigned*)((const bf16_t*)(ws + WS_GLU) + 2 * tc);
              f32x2 win[38];
              { unsigned hv[30];
#pragma unroll
                for (int j = 0; j < 30; ++j) hv[j] = pg[(size_t)(has_halo ? t0 - 30 + j : t0) * (CONVC / 2)];
#pragma unroll
                for (int j = 0; j < 30; ++j) win[j] = has_halo ? (f32x2){bf_lo(hv[j]), bf_hi(hv[j])} : (f32x2){0.f, 0.f}; }
              unsigned nv[4][8];
#pragma unroll
              for (int q = 0; q < 4; ++q)
#pragma unroll
                  for (int u = 0; u < 8; ++u) nv[q][u] = pg[(size_t)(t0 + 8 * q + u) * (CONVC / 2)];
#define R1_STEP(g, sl) do { const int tg = t0 + 8 * (g); \
                  _Pragma("unroll") for (int u = 0; u < 8; ++u) win[30 + u] = (f32x2){bf_lo(nv[sl][u]), bf_hi(nv[sl][u])}; \
                  if ((g) + 4 < 16) { _Pragma("unroll") for (int u = 0; u < 8; ++u) nv[sl][u] = pg[(size_t)(tg + 32 + u) * (CONVC / 2)]; } \
                  LAS float* cb = cbuf + ((g) & 1) * 4096; \
                  _Pragma("unroll") for (int u = 0; u < 8; u += 2) { f32x2 a2 = bias2, b2 = bias2; \
                      _Pragma("unroll") for (int j = 0; j < CONVW; ++j) { a2 += w2[j] * win[u + j]; b2 += w2[j] * win[u + 1 + j]; } \
                      *(LAS f32x2*)(cb + u * 512 + 2 * tc) = a2; *(LAS f32x2*)(cb + (u + 1) * 512 + 2 * tc) = b2; __builtin_amdgcn_sched_barrier(0); } \
                  _Pragma("unroll") for (int j = 0; j < 30; ++j) win[j] = win[j + 8]; \
                  R1_BAR(); } while (0)
              for (int gb = 0; gb < 16; gb += 4) { R1_STEP(gb, 0); R1_STEP(gb + 1, 1); R1_STEP(gb + 2, 2); R1_STEP(gb + 3, 3); }
#undef R1_STEP
              R1_BAR();
          } else {
              float lg[8], lb[8], gq[8], gk[8];
#pragma unroll
              for (int e = 0; e < 8; ++e) { lg[e] = P.conv_ln_g[8 * lane + e]; lb[e] = P.conv_ln_b[8 * lane + e]; gq[e] = lane < 48 ? P.g_q_a[8 * lane + e] : 0.f; gk[e] = lane < 32 ? P.g_kv_a[8 * lane + e] : 0.f; }
              const int tb = t0 + (wave - 4) * 32;
              u32x4 bq[4][2], bk[4][2]; bf16_t b1[4][2], b2[4][2]; float bc[4][2], bs[4][2];
#define R1_BLOAD(sl, g) do { _Pragma("unroll") for (int k = 0; k < 2; ++k) { const int t = tb + 2 * (g) + k; const bf16_t* pr = proj + (size_t)t * PROJ_LD; const u32x4 z = {0u, 0u, 0u, 0u}; \
                      bq[sl][k] = lane < 48 ? *(const u32x4*)(pr + 8 * lane) : z; bk[sl][k] = lane < 32 ? *(const u32x4*)(pr + QL + 8 * lane) : z; \
                      b1[sl][k] = lane < 16 ? pr[QL + KVL + lane] : (bf16_t)0; b2[sl][k] = lane < 16 ? pr[QL + KVL + 16 + lane] : (bf16_t)0; \
                      bc[sl][k] = lane < 16 ? cs[((size_t)t * 16 + lane) * 2] : 0.f; bs[sl][k] = lane < 16 ? cs[((size_t)t * 16 + lane) * 2 + 1] : 0.f; } } while (0)
#define R1_BCOMP(sl, g) do { _Pragma("unroll") for (int k = 0; k < 2; ++k) { const int t = tb + 2 * (g) + k; \
                      float fq[8], fk[8]; unpack8(bq[sl][k], fq); unpack8(bk[sl][k], fk); float sq = 0.f, sk = 0.f; \
                      _Pragma("unroll") for (int e = 0; e < 8; ++e) { sq += fq[e] * fq[e]; sk += fk[e] * fk[e]; } \
                      const float rq = __builtin_amdgcn_rsqf(wave_sum(sq) * (1.0f / QL) + EPS), rk = __builtin_amdgcn_rsqf(wave_sum(sk) * (1.0f / KVL) + EPS); \
                      _Pragma("unroll") for (int e = 0; e < 8; ++e) { fq[e] = fq[e] * rq * gq[e]; fk[e] = fk[e] * rk * gk[e]; } \
                      if (lane < 48) *(u32x4*)(qan + (size_t)t * QL + 8 * lane) = pack8(fq); \
                      if (lane < 32) *(u32x4*)(kvan + (size_t)t * KVL + 8 * lane) = pack8(fk); \
                      { const float x1 = bf1(b1[sl][k]), x2 = bf1(b2[sl][k]); const unsigned o = pk2(x1 * bc[sl][k] - x2 * bs[sl][k], x1 * bs[sl][k] + x2 * bc[sl][k]); \
                        const int sh = 4 * (lane & 3); u32x4 kv4; \
                        kv4.x = (unsigned)__shfl((int)o, sh); kv4.y = (unsigned)__shfl((int)o, sh + 1); kv4.z = (unsigned)__shfl((int)o, sh + 2); kv4.w = (unsigned)__shfl((int)o, sh + 3); \
                        if (lane < 32) *(u32x4*)(Kb + (size_t)t * NQ + (lane >> 2) * 96 + 64 + 2 * sh) = kv4; } } } while (0)
#define R1_LN(gp) do { const LAS float* cb = cbuf + ((gp) & 1) * 4096; \
                  _Pragma("unroll") for (int k = 0; k < 2; ++k) { const int u = (wave - 4) * 2 + k; \
                      const LAS f32x4* rp = (const LAS f32x4*)(cb + u * 512 + 8 * lane); const f32x4 a = rp[0], b4 = rp[1]; float v[8]; \
                      _Pragma("unroll") for (int e = 0; e < 4; ++e) { v[e] = a[e]; v[4 + e] = b4[e]; } \
                      float sm = 0.f; _Pragma("unroll") for (int e = 0; e < 8; ++e) sm += v[e]; \
                      const float mean = wave_sum(sm) * (1.0f / CONVC); float q = 0.f; \
                      _Pragma("unroll") for (int e = 0; e < 8; ++e) { v[e] -= mean; q += v[e] * v[e]; } \
                      const float rstd = __builtin_amdgcn_rsqf(wave_sum(q) * (1.0f / CONVC) + EPS); \
                      _Pragma("unroll") for (int e = 0; e < 8; ++e) { const float y = v[e] * rstd * lg[e] + lb[e]; v[e] = y * fast_sigmoid(y); } \
                      *(u32x4*)(cat + (size_t)(t0 + 8 * (gp) + u) * DM + 512 + 8 * lane) = pack8(v); } } while (0)
#define R1_LSTEP(g, sl) do { if ((g) >= 1) R1_LN((g) - 1); R1_BCOMP(sl, g); if ((g) + 4 < 16) R1_BLOAD(sl, (g) + 4); R1_BAR(); } while (0)
              R1_BLOAD(0, 0); R1_BLOAD(1, 1); R1_BLOAD(2, 2); R1_BLOAD(3, 3);
              for (int gb = 0; gb < 16; gb += 4) { R1_LSTEP(gb, 0); R1_LSTEP(gb + 1, 1); R1_LSTEP(gb + 2, 2); R1_LSTEP(gb + 3, 3); }
              R1_LN(15); R1_BAR();
#undef R1_LSTEP
#undef R1_LN
#undef R1_BCOMP
#undef R1_BLOAD
          }
#undef R1_BAR
          __syncthreads();
        }
    }
}

constexpr int KROW = 208, VROW = 144, KBUF = 64 * KROW, VBUF = 64 * VROW, ABUF = KBUF + VBUF;
constexpr float ATT_THR = 8.0f;
__device__ __forceinline__ int crow(int r, int hi) { return (r & 3) + 8 * (r >> 2) + 4 * hi; }
__device__ __forceinline__ float max3f(float a, float b, float c) { return fmaxf(fmaxf(a, b), c); }
template <bool PRE>
__device__ __forceinline__ float attn_half(f32x16& c, const f32x16& b, f32x16& n, f32x16& o0, f32x16& o1, float& lsum, const LAS unsigned char* kn, const LAS unsigned char* kn2, const LAS unsigned char* vb,
                                           const bf16x8 (&qr)[6], const f32x16& negm, bf16x8& f0, bf16x8& f1) {
    float ps = 0.f, mxb;
    bf16x8 f2, va0, va1, vb0, vb1;
#define ATT_EXP(r) do { c[r] = __builtin_amdgcn_exp2f(c[r]); ps += c[r]; } while (0)
#define ATT_KRD(dst, d0) do { dst = *(const LAS bf16x8*)(kn + (d0) * 32); } while (0)
#define ATT_QKC(src, d0) do { n = __builtin_amdgcn_mfma_f32_32x32x16_bf16(src, qr[d0], (d0) == 0 ? negm : n, 0, 0, 0); } while (0)
#define ATT_FENCE() __builtin_amdgcn_sched_barrier(0)
    ATT_KRD(f2, 2); ATT_FENCE(); ATT_QKC(f0, 0); ATT_EXP(0); ATT_EXP(1); ATT_EXP(2); mxb = max3f(b[0], b[1], b[2]); mxb = max3f(mxb, b[3], b[4]); ATT_FENCE();
    ATT_KRD(f0, 3); ATT_FENCE(); ATT_QKC(f1, 1); ATT_EXP(3); ATT_EXP(4); ATT_EXP(5); mxb = max3f(mxb, b[5], b[6]); mxb = max3f(mxb, b[7], b[8]); ATT_FENCE();
    ATT_KRD(f1, 4); ATT_FENCE(); ATT_QKC(f2, 2); ATT_EXP(6); ATT_EXP(7); ATT_EXP(8); mxb = max3f(mxb, b[9], b[10]); ATT_FENCE();
    ATT_KRD(f2, 5); va0 = *(const LAS bf16x8*)(vb); va1 = *(const LAS bf16x8*)(vb + 32 * VROW); ATT_FENCE(); ATT_QKC(f0, 3); ATT_EXP(9); ATT_EXP(10); ATT_EXP(11); mxb = max3f(mxb, b[11], b[12]); ATT_FENCE();
    vb0 = *(const LAS bf16x8*)(vb + 32); vb1 = *(const LAS bf16x8*)(vb + 32 * VROW + 32); if (PRE) f0 = *(const LAS bf16x8*)(kn2); ATT_FENCE(); ATT_QKC(f1, 4); ATT_EXP(12); ATT_EXP(13); mxb = max3f(mxb, b[13], b[14]); ATT_FENCE();
    if (PRE) f1 = *(const LAS bf16x8*)(kn2 + 32); ATT_FENCE(); ATT_QKC(f2, 5); ATT_EXP(14); ATT_EXP(15); mxb = fmaxf(mxb, b[15]); ATT_FENCE();
#undef ATT_EXP
#undef ATT_KRD
#undef ATT_QKC
    lsum += ps;
    const float mxo = __shfl_xor(mxb, 32);
    { u32x4 pw; pw.x = pk2(c[0], c[1]); pw.y = pk2(c[2], c[3]); pw.z = pk2(c[4], c[5]); pw.w = pk2(c[6], c[7]); const bf16x8 pb = __builtin_bit_cast(bf16x8, pw);
      o0 = __builtin_amdgcn_mfma_f32_32x32x16_bf16(va0, pb, o0, 0, 0, 0); o1 = __builtin_amdgcn_mfma_f32_32x32x16_bf16(va1, pb, o1, 0, 0, 0); ATT_FENCE(); }
    { u32x4 pw; pw.x = pk2(c[8], c[9]); pw.y = pk2(c[10], c[11]); pw.z = pk2(c[12], c[13]); pw.w = pk2(c[14], c[15]); const bf16x8 pb = __builtin_bit_cast(bf16x8, pw);
      o0 = __builtin_amdgcn_mfma_f32_32x32x16_bf16(vb0, pb, o0, 0, 0, 0); o1 = __builtin_amdgcn_mfma_f32_32x32x16_bf16(vb1, pb, o1, 0, 0, 0); ATT_FENCE(); }
#undef ATT_FENCE
    return fmaxf(mxb, mxo);
}
__device__ __forceinline__ void attn_unit(int b, int h, int qb, const bf16_t* Q, const bf16_t* K, const bf16_t* Vt, const float* cs, bf16_t* O, LAS unsigned char* lds, int tid, int wid, int lane) {
    const int r32 = lane & 31, hi = lane >> 5;
    const int q0 = qb * 256, qrow = q0 + wid * 32 + r32; const long tok = (long)b * SEQ + qrow;
    bf16x8 qr[6];
#pragma unroll
    for (int d0 = 0; d0 < 6; ++d0) qr[d0] = *(const bf16x8*)(Q + tok * NQ + h * 96 + d0 * 16 + hi * 8);
#pragma unroll
    for (int d0 = 4; d0 < 6; ++d0) { const int i0 = 8 * (d0 - 4) + 4 * hi; const f32x4* tp = (const f32x4*)(cs + (tok * 16 + i0) * 2); const f32x4 a = tp[0], c = tp[1];
        float f[8]; unpack8(__builtin_bit_cast(u32x4, qr[d0]), f); float g[8];
        g[0] = f[0] * a[0] - f[1] * a[1]; g[1] = f[0] * a[1] + f[1] * a[0]; g[2] = f[2] * a[2] - f[3] * a[3]; g[3] = f[2] * a[3] + f[3] * a[2];
        g[4] = f[4] * c[0] - f[5] * c[1]; g[5] = f[4] * c[1] + f[5] * c[0]; g[6] = f[6] * c[2] - f[7] * c[3]; g[7] = f[6] * c[3] + f[7] * c[2];
        qr[d0] = __builtin_bit_cast(bf16x8, pack8(g)); }
    const bf16_t* Kh = K + (long)b * SEQ * NQ + h * 96;
    const bf16_t* Vh = Vt + ((long)b * 512 + h * 64) * SEQ;
    const int kr0 = tid / 12, kc0 = tid % 12, kr1 = (tid + 512) / 12, kc1 = (tid + 512) % 12; const bool k1 = tid < 256;
    const int vr = tid >> 3, vc = tid & 7;
    unsigned kvo0 = (unsigned)(kr0 * NQ + kc0 * 8) * 2u, kvo1 = (unsigned)(kr1 * NQ + kc1 * 8) * 2u, vvo = (unsigned)(vr * SEQ + vc * 8) * 2u;
    unsigned ksto0 = (unsigned)(kr0 * KROW + kc0 * 16), ksto1 = (unsigned)(kr1 * KROW + kc1 * 16), vsto = (unsigned)(KBUF + vr * VROW + (vc >> 1) * 32 + (vc & 1) * 8);
    unsigned kbase = (unsigned)(r32 * KROW + hi * 16), vbase = (unsigned)(KBUF + r32 * VROW + hi * 16);
    asm volatile("" : "+v"(kvo0), "+v"(kvo1), "+v"(vvo), "+v"(ksto0), "+v"(ksto1), "+v"(vsto), "+v"(kbase), "+v"(vbase));
    const int NT = 4 * (qb + 1);
    u32x4 sk0, sk1 = {0u, 0u, 0u, 0u}, sv;
#define ATT_LOAD(t) do { const char* kt_ = (const char*)(Kh + (long)(64 * (t)) * NQ); const char* vt_ = (const char*)(Vh + 64 * (t)); \
        sk0 = *(const u32x4*)(kt_ + kvo0); if (k1) sk1 = *(const u32x4*)(kt_ + kvo1); sv = *(const u32x4*)(vt_ + vvo); } while (0)
#define ATT_STORE(boff) do { LAS unsigned char* kb_ = lds + (boff); *(LAS u32x4*)(kb_ + ksto0) = sk0; if (k1) *(LAS u32x4*)(kb_ + ksto1) = sk1; \
        { LAS unsigned char* vp_ = kb_ + vsto; u32x2 lo_ = {sv.x, sv.y}, hi_ = {sv.z, sv.w}; *(LAS u32x2*)vp_ = lo_; *(LAS u32x2*)(vp_ + 16) = hi_; } } while (0)
    ATT_LOAD(0); ATT_STORE(0);
    ATT_LOAD(1); ATT_STORE(ABUF);
    __syncthreads();
    f32x16 o0 = {}, o1 = {};
    float m_ref = 0.f, lsum = 0.f;
    const int wq_lo = q0 + wid * 32, wq_hi = wq_lo + 31;
    f32x16 pa, pb, pc, negm = {};
#define ATT_DECIDE(mx, X, Y) do { if (__any((mx) > ATT_THR)) { \
            const float d_ = fmaxf((mx), 0.f); const float alpha = __builtin_amdgcn_exp2f(-d_); m_ref += d_; lsum *= alpha; \
            _Pragma("unroll") for (int r = 0; r < 16; ++r) { o0[r] *= alpha; o1[r] *= alpha; X[r] -= d_; Y[r] -= d_; negm[r] = -m_ref; } } } while (0)
#define ATT_MASK(X, hs) do { if (32 * (hs) + 31 > wq_lo) { const int kv0 = 32 * (hs); \
            _Pragma("unroll") for (int r = 0; r < 16; ++r) { if (kv0 + crow(r, hi) > qrow) X[r] = -INFINITY; } } } while (0)
    { const f32x16 zero = {};
#pragma unroll
      for (int d0 = 0; d0 < 6; ++d0) { const bf16x8 a0 = *(const LAS bf16x8*)(lds + kbase + d0 * 32); pa = __builtin_amdgcn_mfma_f32_32x32x16_bf16(a0, qr[d0], d0 == 0 ? zero : pa, 0, 0, 0); }
#pragma unroll
      for (int d0 = 0; d0 < 6; ++d0) { const bf16x8 a0 = *(const LAS bf16x8*)(lds + kbase + 32 * KROW + d0 * 32); pb = __builtin_amdgcn_mfma_f32_32x32x16_bf16(a0, qr[d0], d0 == 0 ? zero : pb, 0, 0, 0); }
      ATT_MASK(pa, 0);
      float mx = fmaxf(pa[0], pa[1]);
#pragma unroll
      for (int r = 2; r < 16; r += 2) mx = max3f(mx, pa[r], pa[r + 1]);
      mx = fmaxf(mx, __shfl_xor(mx, 32));
      ATT_DECIDE(mx, pa, pb); }
#define ATT_HSTEP(C, B, N, hs, KN, KN2, VB, PRE) do { \
        if (32 * (hs) <= wq_hi) { \
            if (((hs) & 1) == 0) { kf0 = *(const LAS bf16x8*)(KN); kf1 = *(const LAS bf16x8*)((KN) + 32); } \
            const bool needb_ = 32 * ((hs) + 1) <= wq_hi; \
            if (needb_) ATT_MASK(B, (hs) + 1); \
            const float mx_ = attn_half<PRE>(C, B, N, o0, o1, lsum, (KN), (KN2), (VB), qr, negm, kf0, kf1); \
            if (needb_) ATT_DECIDE(mx_, B, N); \
        } } while (0)
#define ATT_TILE(t, CUR, NXT, NN, A0, A1, A2) do { \
        if ((t) + 2 < NT) ATT_LOAD((t) + 2); \
        ATT_HSTEP(A0, A1, A2, 2 * (t), lds + (NXT) * ABUF + kbase, lds + (NXT) * ABUF + kbase + 32 * KROW, lds + (CUR) * ABUF + vbase, true); \
        ATT_HSTEP(A1, A2, A0, 2 * (t) + 1, lds + (NXT) * ABUF + kbase + 32 * KROW, lds, lds + (CUR) * ABUF + vbase + 64, false); \
        if ((t) + 2 < NT) ATT_STORE((NN) * ABUF); \
        __syncthreads(); } while (0)
    bf16x8 kf0 = {}, kf1 = {};
    for (int t = 0; t < NT; t += 3) {
        ATT_TILE(t, 0, 1, 2, pa, pb, pc);
        if (t + 1 >= NT) break;
        ATT_TILE(t + 1, 1, 2, 0, pc, pa, pb);
        if (t + 2 >= NT) break;
        ATT_TILE(t + 2, 2, 0, 1, pb, pc, pa);
    }
#undef ATT_TILE
#undef ATT_HSTEP
#undef ATT_MASK
#undef ATT_DECIDE
#undef ATT_LOAD
#undef ATT_STORE
    lsum += __shfl_xor(lsum, 32);
    const float inv = 1.0f / lsum;
    bf16_t* op = O + tok * DM + h * 64;
#pragma unroll
    for (int g = 0; g < 4; ++g) {
        u32x2 a, d; a.x = pk2(o0[4 * g] * inv, o0[4 * g + 1] * inv); a.y = pk2(o0[4 * g + 2] * inv, o0[4 * g + 3] * inv);
        d.x = pk2(o1[4 * g] * inv, o1[4 * g + 1] * inv); d.y = pk2(o1[4 * g + 2] * inv, o1[4 * g + 3] * inv);
        *(u32x2*)(op + 8 * g + 4 * hi) = a; *(u32x2*)(op + 32 + 8 * g + 4 * hi) = d;
    }
}
__device__ __forceinline__ void phase_attn(const Params& P, LAS unsigned char* lds, int vcu, int G, int tid, int wave, int lane) {
    unsigned char* ws = P.ws;
    const bf16_t* Q = (const bf16_t*)(ws + WS_Q); const bf16_t* K = (const bf16_t*)(ws + WS_K); const bf16_t* Vt = (const bf16_t*)(ws + WS_VT); bf16_t* O = (bf16_t*)(ws + WS_CAT);
    for (int v = vcu; v < 256; v += G) {
        const int bh = v >> 2, j = v & 3;
        for (int i = 0; i < 4; ++i) { const int qb = (i == 0) ? 15 - 2 * j : (i == 1) ? 2 * j : (i == 2) ? 14 - 2 * j : 2 * j + 1;
            attn_unit(bh >> 3, bh & 7, qb, Q, K, Vt, (const float*)(ws + WS_CS), O, lds, tid, wave, lane); }
    }
}

#define XB_TMO      128
#define XB_XCNT(j)  (256  + 64 * (j))
#define XB_XSUB(j)  (1280 + 64 * (j))
#define XB_XGEN(j)  (2304 + 64 * (j))
#define XB_TOP      3328
#define XB_TOPGEN   3392
#define XCD_BAR_WORDS 3456
#define XB_SPIN_CAP (1u << 18)

__device__ __forceinline__ unsigned xb_ld(unsigned* p)              { return __hip_atomic_load(p, __ATOMIC_RELAXED, __HIP_MEMORY_SCOPE_AGENT); }
__device__ __forceinline__ unsigned xb_add(unsigned* p, unsigned v) { return __hip_atomic_fetch_add(p, v, __ATOMIC_RELAXED, __HIP_MEMORY_SCOPE_AGENT); }
__device__ __forceinline__ unsigned xb_xcc_id() { return (unsigned)__builtin_amdgcn_s_getreg((3 << 11) | 20) & 0xFu; }
#define XB_SPIN(cond, bar) do { unsigned _sp = 0; while (cond) { __builtin_amdgcn_s_sleep(1); \
    if ((++_sp & 255u) == 0u) { if (xb_ld(&(bar)[XB_TMO])) break; if (_sp > XB_SPIN_CAP) { atomicAdd(&(bar)[XB_TMO], 1u); break; } } } } while (0)

struct XcdBarrier {
    unsigned* bar; unsigned x;
    volatile LAS unsigned* st;
};

__device__ __forceinline__ XcdBarrier xcd_barrier_post(unsigned* bar, volatile LAS unsigned* st) {
    XcdBarrier b; b.bar = bar; b.x = xb_xcc_id(); b.st = st;
    if (threadIdx.x == 0) (void)xb_add(&bar[XB_XCNT(b.x)], 1u);
    return b;
}
__device__ __forceinline__ void xcd_barrier_complete(unsigned* bar, unsigned x, unsigned& nloc, unsigned& nx) {
    const unsigned G = gridDim.x * gridDim.y * gridDim.z;
    unsigned sum, cnt, mine, sp = 0u;
    for (;;) {
        sum = 0u; cnt = 0u; mine = 0u;
#pragma unroll
        for (unsigned j = 0; j < 16; ++j) { const unsigned c = xb_ld(&bar[XB_XCNT(j)]); sum += c; cnt += (c > 0u) ? 1u : 0u; mine = (j == x) ? c : mine; }
        if (sum == G) break;
        __builtin_amdgcn_s_sleep(1);
        if ((++sp & 255u) == 0u) { if (xb_ld(&bar[XB_TMO])) break; if (sp > XB_SPIN_CAP) { atomicAdd(&bar[XB_TMO], 1u); break; } }
    }
    nloc = mine > 0u ? mine : 1u; nx = cnt > 0u ? cnt : 1u;
}

__device__ __forceinline__ void xcd_barrier(const XcdBarrier& b) {
    asm volatile("s_waitcnt vmcnt(0)" ::: "memory");
    __syncthreads();
    if (threadIdx.x == 0) {
        unsigned* bar = b.bar;
        __builtin_amdgcn_s_waitcnt(0);
        unsigned nloc = b.st[0], nx = b.st[1];
        if (nloc == 0u) { xcd_barrier_complete(bar, b.x, nloc, nx); b.st[0] = nloc; b.st[1] = nx; }
        const unsigned old = xb_add(&bar[XB_XSUB(b.x)], 1u);
        const unsigned gen = old / nloc;
        if (old + 1u == (gen + 1u) * nloc) {
            __builtin_amdgcn_fence(__ATOMIC_RELEASE, "agent");
            asm volatile("s_waitcnt vmcnt(0)" ::: "memory");
            const unsigned og = xb_add(&bar[XB_TOP], 1u);
            const unsigned tg = og / nx;
            if (og + 1u == (tg + 1u) * nx) xb_add(&bar[XB_TOPGEN], 1u);
            else XB_SPIN(xb_ld(&bar[XB_TOPGEN]) == tg, bar);
            __builtin_amdgcn_fence(__ATOMIC_ACQUIRE, "agent");
            xb_add(&bar[XB_XGEN(b.x)], 1u);
            asm volatile("s_waitcnt vmcnt(0)" ::: "memory");
        } else {
            XB_SPIN(xb_ld(&bar[XB_XGEN(b.x)]) == gen, bar);
            __builtin_amdgcn_fence(__ATOMIC_ACQUIRE, "agent");
            asm volatile("s_waitcnt vmcnt(0)" ::: "memory");
        }
    }
    __syncthreads();
}

__global__ void __launch_bounds__(512) hymba_fwd(Params P) {
    extern __shared__ __attribute__((aligned(16))) unsigned char lds_raw[];
    LAS unsigned char* lds = (LAS unsigned char*)lds_raw;
    const int tid = threadIdx.x, lane = tid & 63, wave = __builtin_amdgcn_readfirstlane(tid >> 6);
    const int G = gridDim.x, bx = blockIdx.x;
    const int vcu = (G % 8 == 0) ? (bx % 8) * (G / 8) + bx / 8 : bx;
    unsigned char* ws = P.ws;
    bf16_t* XB = (bf16_t*)(ws + WS_XB);
    const int lo = P.ph_lo, hi = P.ph_hi;
    volatile LAS unsigned* bst = (volatile LAS unsigned*)(lds + 131072 + 512);
    if (tid < 2) bst[tid] = 0u;
    __syncthreads();
    XcdBarrier bar; bar.bar = (unsigned*)(ws + WS_BAR); bar.x = 0; bar.st = bst;
#ifndef PHASE_MASK
#define PHASE_MASK 0x1FF
#endif
#ifndef REP_MASK
#define REP_MASK 0x000
#endif
#define IN(k) ((((PHASE_MASK) >> (k)) & 1) && lo <= (k) && (k) < hi)
#define SEAM(k) do { if (IN(k) && IN((k) + 1)) { if ((k) == 0) cg::this_grid().sync(); else xcd_barrier(bar); } } while (0)
    if (IN(0)) { phase_prologue(P, lds, vcu, G, wave, lane);
        { u32x4* zc = (u32x4*)(ws + WS_CTL); const u32x4 z = {0u, 0u, 0u, 0u}; const int gtz = (vcu * 8 + wave) * 64 + lane;
          for (int i = gtz; i < (int)((CTL_BYTES + BAR_BYTES + FLAG_BYTES + ROWSS_BYTES) / 16); i += G * 512) zc[i] = z; }
        __syncthreads(); } SEAM(0);
    if (hi - lo > 1) bar = xcd_barrier_post((unsigned*)(ws + WS_BAR), bst);
    if (IN(1)) { { EpiProj E{(bf16_t*)(ws + WS_PROJ), (bf16_t*)(ws + WS_GLU)};
          run_gemm(lds, XB, (const bf16_t*)(ws + WS_WIN), TT, NPROJ_P, DM, G, bx, E); }
        { const bool hiw = bx >= G / 2; const size_t ro = hiw ? 0 : 24576;
          EpiPe E{(bf16_t*)(ws + WS_PE) + ro * DM, (float*)(ws + WS_ROWSS) + ro};
          run_gemm(lds, (const bf16_t*)(ws + WS_PBF) + ro * PLE, (const bf16_t*)(ws + WS_WPP), hiw ? 24576 : 8192, DM, PLE, G / 2, hiw ? bx - G / 2 : bx, E); }
    } SEAM(1);
    if (IN(2)) { phase_r1(P, lds, vcu, G, tid, wave, lane); } SEAM(2);
    if (IN(3)) {
#pragma nounroll
        for (int gi = 0; gi < 3; ++gi) {
            const bf16_t* A = (const bf16_t*)(ws + (gi == 0 ? WS_QAN : gi == 1 ? WS_KVAN : WS_WV));
            const bf16_t* Bt = (const bf16_t*)(ws + (gi == 0 ? WS_WQ : gi == 1 ? WS_WK : WS_KVAN));
            const int M = gi == 2 ? 512 : TT, N = gi == 0 ? NQ : gi == 1 ? 512 : TT, K = gi == 0 ? QL : KVL;
            EpiStore E{(bf16_t*)(ws + (gi == 0 ? WS_Q : gi == 1 ? WS_K : WS_VT)), gi == 2 ? (long)SEQ : (long)NQ, gi == 0 ? 30 : gi == 1 ? 6 : 12, gi == 1 ? 96L : gi == 2 ? 512L * SEQ : 0L};
            const bool upk = gi == 1; const bool hiw = bx >= G / 2;
            run_gemm(lds, A, Bt, (upk && !hiw) ? 0 : M, N, K, upk ? G / 2 : G, (upk && hiw) ? bx - G / 2 : bx, E);
        }
    } SEAM(3);
    if (IN(4)) { phase_attn(P, lds, vcu, G, tid, wave, lane); } SEAM(4);
    if (IN(5)) {
        PanelSumsq s1{(float*)(ws + WS_SLOT), (unsigned*)(ws + WS_CTL), 0, EPS}, s2{(float*)(ws + WS_SLOT + SLOT_BANK), (unsigned*)(ws + WS_CTL) + 128 * 64, 0, EPS};
        EpiWo E{P.x, (bf16_t*)(ws + WS_H1B), XB, P.g_mix_post, P.g_ffn_pre, s1, s2, lds + 131072 + 5120};
        run_gemm(lds, (const bf16_t*)(ws + WS_CAT), (const bf16_t*)(ws + WS_WO), TT, DM, DM, G, bx, E);
    } SEAM(5);
    if (IN(6)) { EpiGU E{(bf16_t*)(ws + WS_ACT), P.dw_w, P.dw_b, (float*)(ws + WS_HALO), (unsigned*)(ws + WS_FLAG), (PG8_LAS float*)(lds + 131072 + 1024)};
        run_gemm(lds, XB, (const bf16_t*)(ws + WS_WG), TT, 2 * DFF, DM, G, bx, E); } SEAM(6);
    if (IN(7)) {
        PanelSumsq s3{(float*)(ws + WS_SLOT + 2 * SLOT_BANK), (unsigned*)(ws + WS_CTL) + 2 * 128 * 64, 0, EPS};
        EpiDown E{(const bf16_t*)(ws + WS_H1B), XB, P.g_ffn_post, s3, lds + 131072 + 5120};
        run_gemm(lds, (const bf16_t*)(ws + WS_ACT), (const bf16_t*)(ws + WS_WD), TT, DM, DFF, G, bx, E);
    } SEAM(7);
    if (IN(8)) { EpiOut E{P.out, XB, (const bf16_t*)(ws + WS_PE), (const float*)(ws + WS_ROWSS), P.g_ple};
        run_gemm(lds, XB, (const bf16_t*)(ws + WS_WPG), TT, DM, DM, G, bx, E); }
#undef IN
#undef SEAM
}

#ifndef N_LAUNCHES
#define N_LAUNCHES 1
#endif
extern "C" void kernel_launch(void* const* d_in, const int* in_sizes, int n_in, void* d_out, int out_size, void* d_ws, size_t ws_size, hipStream_t stream) {
    static int grid = 0;
    if (grid == 0) {
        if (n_in != 25 || in_sizes[0] != TT * DM || out_size != TT * DM || ws_size < WS_END) {
            fprintf(stderr, "kernel_launch: unexpected problem: n_in %d in0 %d out %d ws %zu (need %zu)\n", n_in, n_in > 0 ? in_sizes[0] : -1, out_size, ws_size, (size_t)WS_END); grid = -1; return; }
        int dev = 0, cus = 0, per_cu = 0;
        hipGetDevice(&dev); hipDeviceGetAttribute(&cus, hipDeviceAttributeMultiprocessorCount, dev);
        if (hipFuncSetAttribute((const void*)hymba_fwd, hipFuncAttributeMaxDynamicSharedMemorySize, LDS_BYTES) != hipSuccess) { fprintf(stderr, "kernel_launch: hipFuncSetAttribute failed\n"); grid = -1; return; }
        if (hipOccupancyMaxActiveBlocksPerMultiprocessor(&per_cu, (const void*)hymba_fwd, 512, LDS_BYTES) != hipSuccess || per_cu < 1) { fprintf(stderr, "kernel_launch: occupancy query says %d\n", per_cu); per_cu = 1; }
        (void)hipGetLastError();
        grid = 256;
        if (cus != 256) fprintf(stderr, "kernel_launch: device has %d CUs, kernel is built for 256\n", cus);
    }
    if (grid < 0) return;
    Params a{};
    a.x = (const float*)d_in[0]; a.p = (const float*)d_in[1]; a.pos = (const int*)d_in[2];
    a.g_mix_pre = (const float*)d_in[3]; a.w_in = (const float*)d_in[4]; a.g_q_a = (const float*)d_in[5]; a.w_q_b = (const float*)d_in[6];
    a.g_kv_a = (const float*)d_in[7]; a.w_kv_b = (const float*)d_in[8]; a.conv_w = (const float*)d_in[9]; a.conv_b = (const float*)d_in[10];
    a.conv_ln_g = (const float*)d_in[11]; a.conv_ln_b = (const float*)d_in[12]; a.w_o = (const float*)d_in[13]; a.g_mix_post = (const float*)d_in[14];
    a.g_ffn_pre = (const float*)d_in[15]; a.w_gate = (const float*)d_in[16]; a.w_up = (const float*)d_in[17]; a.dw_w = (const float*)d_in[18];
    a.dw_b = (const float*)d_in[19]; a.w_down = (const float*)d_in[20]; a.g_ffn_post = (const float*)d_in[21]; a.w_ple_proj = (const float*)d_in[22];
    a.g_ple = (const float*)d_in[23]; a.w_ple_gate = (const float*)d_in[24];
    a.out = (float*)d_out; a.ws = (unsigned char*)d_ws;
#if N_LAUNCHES == 1
    a.ph_lo = 0; a.ph_hi = NPHASE;
    void* args[] = {&a};
    hipError_t e = hipLaunchCooperativeKernel((const void*)hymba_fwd, dim3(grid), dim3(512), args, LDS_BYTES, stream);
    if (e != hipSuccess) fprintf(stderr, "kernel_launch: cooperative launch failed: %s (grid %d)\n", hipGetErrorString(e), grid);
#else
    for (int ph = 0; ph < NPHASE; ++ph) for (int rep = 0; rep <= (((REP_MASK) >> ph) & 1); ++rep) {
        a.ph_lo = ph; a.ph_hi = ph + 1;
        hipLaunchKernelGGL(hymba_fwd, dim3(grid), dim3(512), LDS_BYTES, stream, a);
    }
#endif
}
```

```cpp
#include <hip/hip_runtime.h>
#include <hip/hip_cooperative_groups.h>
#include <cstdio>
#include <cstdint>
#include <cmath>
namespace cg = cooperative_groups;
namespace pg8 {
#define PG8_LAS __attribute__((address_space(3)))
typedef unsigned short bf16_t;
typedef short bf16x8 __attribute__((ext_vector_type(8)));
typedef float f32x4 __attribute__((ext_vector_type(4)));
typedef unsigned u32x4 __attribute__((ext_vector_type(4)));
constexpr int BM = 256, BK = 64, HALF = 128, HTB = HALF * BK * 2  , STAGE_BYTES = 8 * HTB, NXCD = 8, WGM = 8;

__host__ __device__ __forceinline__ int lds_byte(int r, int c) { const int st = (r >> 4) * 2 + (c >> 5), rr = r & 15, cc = c & 31, ob = rr * 64 + cc * 2; return st * 1024 + (ob ^ (((ob >> 9) & 1) << 5)); }
__host__ __device__ __forceinline__ void stage_rc(int b, int& R, int& C) { const int st = b / 1024, sb = b % 1024, swz = sb ^ (((sb >> 9) & 1) << 5); R = (st >> 1) * 16 + swz / 64; C = (st & 1) * 32 + (swz % 64) / 2; }
__host__ __device__ __forceinline__ int perm32(int rho) { const int n = rho >> 4, i = rho & 15; return 8 * (i >> 2) + 4 * n + (i & 3); }

struct Unit { int pm, pn; };
struct Gemm { const bf16_t* A; const bf16_t* Bt; int M, N, K; };

struct StaticOrder {
    int nM, nN, nwg, G, c;
    __host__ __device__ void init(int M, int N, int G_, int c_) { nM = M / BM; nN = N / BM; nwg = nM * nN; G = G_; c = c_; }
    __host__ __device__ bool next(int i, Unit& u) const {
        const int L = i * G + c; if (L >= nwg) return false;
        int wgid = L; { const int q = nwg / NXCD, r = nwg % NXCD, xcd = wgid % NXCD, off = wgid / NXCD; wgid = (xcd < r ? xcd * (q + 1) : r * (q + 1) + (xcd - r) * q) + off; }
        const int nig = WGM * nN, gid = wgid / nig, fm = gid * WGM, gsz = (nM - fm) < WGM ? (nM - fm) : WGM;
        u.pm = fm + ((wgid % nig) % gsz); u.pn = (wgid % nig) / gsz; return true;
    }
    __device__ __forceinline__ void a_ready(const Unit&) const {}
    __device__ __forceinline__ void done(const Unit&) const {}
};
__device__ __forceinline__ unsigned cvt_pk_bf16(float lo, float hi) { unsigned r; asm volatile("v_cvt_pk_bf16_f32 %0, %1, %2" : "=v"(r) : "v"(lo), "v"(hi)); return r; }
template <class Epi, class Sched, bool ALIGN_EPI = false, bool SP2 = false>
__device__ __forceinline__ void gemm_phase(PG8_LAS unsigned char* lds, const Gemm g, const Sched& S, const Epi& E) {
    const int tid = threadIdx.x, wid = __builtin_amdgcn_readfirstlane(tid >> 6), lane = tid & 63, wr = wid >> 2, wc = wid & 3, fr = lane & 15, fq = lane >> 4;
    const int K = g.K, nt = K / BK;
    unsigned voffA[2], voffB[2];
#pragma unroll
    for (int i = 0; i < 2; ++i) { int R, C; stage_rc(tid * 16 + i * 8192, R, C); const int Rb = Epi::PERM ? ((R & ~31) + perm32(R & 31)) : R;
        voffA[i] = (unsigned)(R * K + C) * 2u; voffB[i] = (unsigned)(Rb * K + C) * 2u; }
    const size_t kstep = (size_t)(BK * 2);
    const size_t hstep = (size_t)HALF * K * 2;
    const size_t tstep = 2 * hstep;
    const unsigned ldsw = (unsigned)wid * 1024u;
    const int aoff = lds_byte(wr * 64 + fr, fq * 8), boff = lds_byte(wc * 32 + fr, fq * 8);
#define PG8_SA(b, h) (((b) * 2 + (h)) * HTB)
#define PG8_SB(b, h) ((4 + (b) * 2 + (h)) * HTB)
#define PG8_STAGE(bufoff, gbase, voff) do { _Pragma("unroll") for (int _i = 0; _i < 2; ++_i) \
        __builtin_amdgcn_global_load_lds((const unsigned*)((const char*)(gbase) + (voff)[_i]), (PG8_LAS unsigned*)(lds + (bufoff) + ldsw + _i * 8192), 16, 0, 0); } while (0)
#define PG8_LDA(dst, b, h) do { _Pragma("unroll") for (int m = 0; m < 4; ++m) _Pragma("unroll") for (int k = 0; k < 2; ++k) dst[m][k] = *(const PG8_LAS bf16x8*)(lds + PG8_SA(b, h) + aoff + m * 2048 + k * 1024); } while (0)
#define PG8_LDB(dst, b, h) do { _Pragma("unroll") for (int n = 0; n < 2; ++n) _Pragma("unroll") for (int k = 0; k < 2; ++k) dst[n][k] = *(const PG8_LAS bf16x8*)(lds + PG8_SB(b, h) + boff + n * 2048 + k * 1024); } while (0)
#define PG8_MMA(ai, bj, At, Bt) do { __builtin_amdgcn_s_setprio(1); _Pragma("unroll") for (int m = 0; m < 4; ++m) _Pragma("unroll") for (int n = 0; n < 2; ++n) _Pragma("unroll") for (int k = 0; k < 2; ++k) \
        acc[ai][bj][m][n] = __builtin_amdgcn_mfma_f32_16x16x32_bf16(Bt[n][k], At[m][k], acc[ai][bj][m][n], 0, 0, 0); __builtin_amdgcn_s_setprio(0); } while (0)
#define PG8_WAIT_V(n) asm volatile("s_waitcnt vmcnt(" #n ")" ::: "memory")
#define PG8_WAIT_L(n) asm volatile("s_waitcnt lgkmcnt(" #n ")" ::: "memory")
#define PG8_BAR __builtin_amdgcn_s_barrier()
#define PG8_SCHED __builtin_amdgcn_sched_barrier(0)
    Unit cur, nxt; int ui = 0;
    if (!S.next(0, cur)) return;
    f32x4 acc[2][2][4][2];
#pragma unroll
    for (int a = 0; a < 2; ++a)
#pragma unroll
        for (int b = 0; b < 2; ++b)
#pragma unroll
            for (int m = 0; m < 4; ++m)
#pragma unroll
                for (int n = 0; n < 2; ++n) acc[a][b][m][n] = (f32x4){0.f, 0.f, 0.f, 0.f};
    bf16x8 At[4][2], B0[2][2], B1[2][2];
    const char* cA = (const char*)g.A + (size_t)cur.pm * tstep; const char* cB = (const char*)g.Bt + (size_t)cur.pn * tstep;
    S.a_ready(cur);
    if constexpr (SP2) {
        PG8_STAGE(PG8_SB(0, 0), cB, voffB); PG8_STAGE(PG8_SB(0, 1), cB + hstep, voffB); PG8_STAGE(PG8_SA(0, 0), cA, voffA); PG8_STAGE(PG8_SA(0, 1), cA + hstep, voffA);
        if (wr == 1) PG8_BAR;
        PG8_WAIT_V(2); PG8_BAR;
        PG8_STAGE(PG8_SB(1, 0), cB + kstep, voffB); PG8_STAGE(PG8_SA(1, 0), cA + kstep, voffA); PG8_STAGE(PG8_SB(1, 1), cB + hstep + kstep, voffB);
        PG8_WAIT_V(6); PG8_BAR;
    } else {
        PG8_STAGE(PG8_SB(0, 0), cB, voffB); PG8_STAGE(PG8_SA(0, 0), cA, voffA); PG8_STAGE(PG8_SB(0, 1), cB + hstep, voffB); PG8_STAGE(PG8_SA(0, 1), cA + hstep, voffA);
        if (wr == 1) PG8_BAR;
        PG8_WAIT_V(4); PG8_BAR;
        PG8_STAGE(PG8_SB(1, 0), cB + kstep, voffB); PG8_STAGE(PG8_SA(1, 0), cA + kstep, voffA); PG8_STAGE(PG8_SB(1, 1), cB + hstep + kstep, voffB);
        PG8_WAIT_V(6); PG8_BAR;
    }
    for (;;) {
        const bool has_next = S.next(ui + 1, nxt);
        const char* nA = has_next ? (const char*)g.A + (size_t)nxt.pm * tstep : cA; const char* nB = has_next ? (const char*)g.Bt + (size_t)nxt.pn * tstep : cB;
        for (int t = 0; t < nt; t += 2) {
            const bool last = (t == nt - 2);
            const char* a1 = cA + (size_t)(t + 1) * kstep;
            const char* a2 = last ? nA : cA + (size_t)(t + 2) * kstep; const char* b2 = last ? nB : cB + (size_t)(t + 2) * kstep;
            const char* a3 = a2 + kstep; const char* b3 = b2 + kstep;
            if (last && has_next) S.a_ready(nxt);
            if constexpr (SP2) {
            PG8_LDB(B0, 0, 0); PG8_LDB(B1, 0, 1); PG8_SCHED; PG8_LDA(At, 0, 0); PG8_STAGE(PG8_SA(1, 1), a1 + hstep, voffA);
            PG8_WAIT_V(8); PG8_WAIT_L(0); PG8_BAR; PG8_MMA(0, 0, At, B0); PG8_MMA(0, 1, At, B1); PG8_BAR; PG8_SCHED;
            PG8_LDA(At, 0, 1); PG8_STAGE(PG8_SB(0, 0), b2, voffB); PG8_STAGE(PG8_SB(0, 1), b2 + hstep, voffB); PG8_STAGE(PG8_SA(0, 0), a2, voffA);
            PG8_WAIT_V(8); PG8_WAIT_L(0); PG8_BAR; PG8_MMA(1, 0, At, B0); PG8_MMA(1, 1, At, B1); PG8_BAR; PG8_SCHED;
            PG8_LDB(B0, 1, 0); PG8_LDB(B1, 1, 1); PG8_SCHED; PG8_LDA(At, 1, 0); PG8_STAGE(PG8_SA(0, 1), a2 + hstep, voffA);
            PG8_WAIT_V(8); PG8_WAIT_L(0); PG8_BAR; PG8_MMA(0, 0, At, B0); PG8_MMA(0, 1, At, B1); PG8_BAR; PG8_SCHED;
            PG8_LDA(At, 1, 1); PG8_STAGE(PG8_SB(1, 0), b3, voffB); PG8_STAGE(PG8_SB(1, 1), b3 + hstep, voffB); PG8_STAGE(PG8_SA(1, 0), a3, voffA);
            PG8_WAIT_V(8); PG8_WAIT_L(0); PG8_BAR; PG8_MMA(1, 0, At, B0); PG8_MMA(1, 1, At, B1); PG8_BAR; PG8_SCHED;
            } else {
            PG8_LDB(B0, 0, 0); PG8_SCHED; PG8_LDA(At, 0, 0); PG8_STAGE(PG8_SA(1, 1), a1 + hstep, voffA);
            PG8_WAIT_L(8); PG8_BAR; PG8_WAIT_L(0); PG8_MMA(0, 0, At, B0); PG8_BAR; PG8_SCHED;
            PG8_LDB(B1, 0, 1); PG8_STAGE(PG8_SB(0, 0), b2, voffB);
            PG8_BAR; PG8_WAIT_L(0); PG8_MMA(0, 1, At, B1); PG8_BAR;
            PG8_LDA(At, 0, 1); PG8_STAGE(PG8_SA(0, 0), a2, voffA);
            PG8_BAR; PG8_WAIT_L(0); PG8_MMA(1, 0, At, B0); PG8_BAR; PG8_SCHED;
            PG8_STAGE(PG8_SB(0, 1), b2 + hstep, voffB);
            PG8_WAIT_V(6); PG8_BAR; PG8_MMA(1, 1, At, B1); PG8_BAR;
            PG8_LDB(B0, 1, 0); PG8_SCHED; PG8_LDA(At, 1, 0); PG8_STAGE(PG8_SA(0, 1), a2 + hstep, voffA);
            PG8_WAIT_L(8); PG8_BAR; PG8_WAIT_L(0); PG8_MMA(0, 0, At, B0); PG8_BAR; PG8_SCHED;
            PG8_LDB(B1, 1, 1); PG8_STAGE(PG8_SB(1, 0), b3, voffB);
            PG8_BAR; PG8_WAIT_L(0); PG8_MMA(0, 1, At, B1); PG8_BAR;
            PG8_LDA(At, 1, 1); PG8_STAGE(PG8_SA(1, 0), a3, voffA);
            PG8_BAR; PG8_WAIT_L(0); PG8_MMA(1, 0, At, B0); PG8_BAR; PG8_SCHED;
            PG8_STAGE(PG8_SB(1, 1), b3 + hstep, voffB);
            PG8_WAIT_V(6); PG8_BAR; PG8_MMA(1, 1, At, B1); PG8_BAR;
            }
        }
        if constexpr (ALIGN_EPI) { if (wr == 0) PG8_BAR; }
        if constexpr (!Epi::AFTER_DRAIN) { E(acc, cur, wr, wc, fr, fq); S.done(cur); }
        if (!has_next) break;
#pragma unroll
        for (int a = 0; a < 2; ++a)
#pragma unroll
            for (int b = 0; b < 2; ++b)
#pragma unroll
                for (int m = 0; m < 4; ++m)
#pragma unroll
                    for (int n = 0; n < 2; ++n) acc[a][b][m][n] = (f32x4){0.f, 0.f, 0.f, 0.f};
        cur = nxt; cA = nA; cB = nB; ++ui;
        if constexpr (ALIGN_EPI) { if (wr == 1) PG8_BAR; }
    }
    PG8_WAIT_V(0);
    if constexpr (!ALIGN_EPI) { if (wr == 0) PG8_BAR; }
    PG8_BAR;
    if constexpr (Epi::AFTER_DRAIN) { E.fused(acc, cur, wr, wc, fr, fq, lds, wid, lane); S.done(cur); }
#undef PG8_SA
#undef PG8_SB
#undef PG8_STAGE
#undef PG8_LDA
#undef PG8_LDB
#undef PG8_MMA
#undef PG8_WAIT_V
#undef PG8_WAIT_L
#undef PG8_BAR
#undef PG8_SCHED
}
}

using pg8::bf16_t; using pg8::f32x4; using pg8::u32x4; using pg8::Unit;
typedef short bf16x8 __attribute__((ext_vector_type(8)));
typedef float f32x16 __attribute__((ext_vector_type(16)));
typedef unsigned u32x2 __attribute__((ext_vector_type(2)));
#define LAS __attribute__((address_space(3)))

constexpr int TT = 32768, SEQ = 4096, DM = 1024, NPROJ = 1696, NPROJ_P = 1792, PROJ_LD = 768, QL = 384, KVL = 256, NQ = 768, DFF = 2816, PLE = 256;
constexpr int NHEAD = 8, CONVC = 512, CONVW = 31;
constexpr float EPS = 1e-6f;
constexpr float QSCALE = 0.10206207261596575f * 1.4426950408889634f;
constexpr size_t MiB = 1u << 20;
constexpr size_t WS_WIN = 1 * MiB, WS_WQ = 5 * MiB, WS_WK = 6 * MiB, WS_WV = 6 * MiB + 512 * 1024, WS_WO = 7 * MiB, WS_WG = 9 * MiB, WS_WU = 15 * MiB,
                 WS_WD = 21 * MiB, WS_WPP = 27 * MiB, WS_WPG = 28 * MiB, WS_CS = 30 * MiB, WS_RSTD = 34 * MiB, WS_CTL = 35 * MiB, WS_SLOT = 36 * MiB;
constexpr size_t CTL_BYTES = 4 * 128 * 256, BAR_BYTES = 16384, WS_BAR = WS_CTL + 4 * 128 * 256, FLAG_BYTES = 16384, WS_FLAG = WS_BAR + 16384, ROWSS_BYTES = 131072, WS_ROWSS = WS_FLAG + 16384, SLOT_BANK = (size_t)128 * 256 * 4 * 4;
constexpr size_t WS_XB = 40 * MiB, WS_PBF = 104 * MiB, WS_PROJ = 120 * MiB, WS_QAN = 232 * MiB, WS_KVAN = 256 * MiB, WS_CAT = 272 * MiB,
                 WS_GLU = 168 * MiB, WS_K = 336 * MiB, WS_Q = 120 * MiB, WS_VT = 168 * MiB, WS_ACT = 120 * MiB, WS_HALO = 296 * MiB, WS_H1B = 336 * MiB, WS_PE = 400 * MiB, WS_END = 472 * MiB;
constexpr int LDS_BYTES = 147456;
constexpr int NPHASE = 9;

struct Params {
    const float* x; const float* p; const int* pos;
    const float *g_mix_pre, *w_in, *g_q_a, *w_q_b, *g_kv_a, *w_kv_b, *conv_w, *conv_b, *conv_ln_g, *conv_ln_b, *w_o, *g_mix_post, *g_ffn_pre,
                *w_gate, *w_up, *dw_w, *dw_b, *w_down, *g_ffn_post, *w_ple_proj, *g_ple, *w_ple_gate;
    float* out; unsigned char* ws; int ph_lo, ph_hi;
};

__device__ __forceinline__ float bf_lo(unsigned w) { return __uint_as_float(w << 16); }
__device__ __forceinline__ float bf_hi(unsigned w) { return __uint_as_float(w & 0xffff0000u); }
__device__ __forceinline__ float bf1(bf16_t h) { return __uint_as_float((unsigned)h << 16); }
__device__ __forceinline__ unsigned pk2(float lo, float hi) { return pg8::cvt_pk_bf16(lo, hi); }
__device__ __forceinline__ float wave_sum(float v) {
#define WS_DPP(ctrl, rmask) v += __int_as_float(__builtin_amdgcn_update_dpp(0, __float_as_int(v), (ctrl), (rmask), 0xf, true))
    WS_DPP(0x111, 0xf); WS_DPP(0x112, 0xf); WS_DPP(0x114, 0xf); WS_DPP(0x118, 0xf);
    WS_DPP(0x142, 0xa);
    WS_DPP(0x143, 0xc);
#undef WS_DPP
    return __int_as_float(__builtin_amdgcn_readlane(__float_as_int(v), 63));
}
__device__ __forceinline__ float fast_sigmoid(float x) { return __builtin_amdgcn_rcpf(1.0f + __builtin_amdgcn_exp2f(-1.4426950408889634f * x)); }
__device__ __forceinline__ float gelu_tanh(float g) {
    const float u = 0.7978845608028654f * (g + 0.044715f * g * g * g);
    return g * __builtin_amdgcn_rcpf(1.0f + __builtin_amdgcn_exp2f(-2.0f * 1.4426950408889634f * u));
}
typedef float f32x2 __attribute__((ext_vector_type(2)));
__device__ __forceinline__ f32x2 fast_sigmoid2(f32x2 x) { const f32x2 z = x * (-1.4426950408889634f); f32x2 e; e.x = __builtin_amdgcn_exp2f(z.x); e.y = __builtin_amdgcn_exp2f(z.y);
    const f32x2 d = e + 1.0f; f32x2 r; r.x = __builtin_amdgcn_rcpf(d.x); r.y = __builtin_amdgcn_rcpf(d.y); return r; }
__device__ __forceinline__ f32x2 gelu_tanh2(f32x2 g) { const f32x2 t = (g * g) * 0.044715f + 1.0f; const f32x2 z = (g * t) * (-2.0f * 0.7978845608028654f * 1.4426950408889634f);
    f32x2 e; e.x = __builtin_amdgcn_exp2f(z.x); e.y = __builtin_amdgcn_exp2f(z.y); const f32x2 d = e + 1.0f; f32x2 r; r.x = __builtin_amdgcn_rcpf(d.x); r.y = __builtin_amdgcn_rcpf(d.y); return g * r; }
__device__ __forceinline__ void unpack8(const u32x4 w, float (&f)[8]) {
    f[0] = bf_lo(w.x); f[1] = bf_hi(w.x); f[2] = bf_lo(w.y); f[3] = bf_hi(w.y); f[4] = bf_lo(w.z); f[5] = bf_hi(w.z); f[6] = bf_lo(w.w); f[7] = bf_hi(w.w);
}
__device__ __forceinline__ u32x4 pack8(const float (&f)[8]) { u32x4 w; w.x = pk2(f[0], f[1]); w.y = pk2(f[2], f[3]); w.z = pk2(f[4], f[5]); w.w = pk2(f[6], f[7]); return w; }

struct EpiStore {
    static constexpr bool PERM = true, AFTER_DRAIN = false;
    bf16_t* O; long ldc; int lg; long S;
    __device__ __forceinline__ void operator()(const f32x4 (&acc)[2][2][4][2], const Unit& u, int wr, int wc, int fr, int fq) const {
        const int row0 = u.pm * 256 + wr * 64 + fr, c0 = u.pn * 256 + wc * 32 + 8 * fq;
#pragma unroll
        for (int bj = 0; bj < 2; ++bj) { const int c = c0 + bj * 128; const long dcol = (long)(c >> lg) * S + (c & ((1 << lg) - 1));
#pragma unroll
            for (int ai = 0; ai < 2; ++ai)
#pragma unroll
                for (int m = 0; m < 4; ++m) { const f32x4 v0 = acc[ai][bj][m][0], v1 = acc[ai][bj][m][1]; u32x4 w;
                    w.x = pk2(v0[0], v0[1]); w.y = pk2(v0[2], v0[3]); w.z = pk2(v1[0], v1[1]); w.w = pk2(v1[2], v1[3]);
                    *(u32x4*)(O + (long)(row0 + ai * 128 + m * 16) * ldc + dcol) = w; } }
    }
};
struct EpiProj {
    static constexpr bool PERM = true, AFTER_DRAIN = false;
    bf16_t* proj; bf16_t* glu;
    __device__ __forceinline__ void operator()(const f32x4 (&acc)[2][2][4][2], const Unit& u, int wr, int wc, int fr, int fq) const {
        const int row0 = u.pm * 256 + wr * 64 + fr, lc = wc * 32 + 8 * fq;
        if (u.pn < 3) {
#pragma unroll
            for (int bj = 0; bj < 2; ++bj)
#pragma unroll
                for (int ai = 0; ai < 2; ++ai)
#pragma unroll
                    for (int m = 0; m < 4; ++m) { const f32x4 v0 = acc[ai][bj][m][0], v1 = acc[ai][bj][m][1]; u32x4 w;
                        w.x = pk2(v0[0], v0[1]); w.y = pk2(v0[2], v0[3]); w.z = pk2(v1[0], v1[1]); w.w = pk2(v1[2], v1[3]);
                        *(u32x4*)(proj + (long)(row0 + ai * 128 + m * 16) * PROJ_LD + u.pn * 256 + bj * 128 + lc) = w; }
        } else {
#pragma unroll
            for (int ai = 0; ai < 2; ++ai)
#pragma unroll
                for (int m = 0; m < 4; ++m) { float o[8];
#pragma unroll
                    for (int e = 0; e < 8; e += 2) { const f32x2 a = {acc[ai][0][m][e >> 2][e & 3], acc[ai][0][m][(e + 1) >> 2][(e + 1) & 3]}, gt = {acc[ai][1][m][e >> 2][e & 3], acc[ai][1][m][(e + 1) >> 2][(e + 1) & 3]};
                        const f32x2 r = a * fast_sigmoid2(gt); o[e] = r.x; o[e + 1] = r.y; }
                    *(u32x4*)(glu + (long)(row0 + ai * 128 + m * 16) * CONVC + (u.pn - 3) * 128 + lc) = pack8(o); }
        }
    }
};
__device__ __forceinline__ float dpp_shr1(float old, float src) { return __int_as_float(__builtin_amdgcn_update_dpp(__float_as_int(old), __float_as_int(src), 0x111, 0xf, 0xf, false)); }
__device__ __forceinline__ float dpp_shr2(float old, float src) { return __int_as_float(__builtin_amdgcn_update_dpp(__float_as_int(old), __float_as_int(src), 0x112, 0xf, 0xf, false)); }
__device__ __forceinline__ float dpp_ror1(float src) { return __int_as_float(__builtin_amdgcn_update_dpp(0, __float_as_int(src), 0x121, 0xf, 0xf, false)); }
__device__ __forceinline__ float dpp_ror2(float src) { return __int_as_float(__builtin_amdgcn_update_dpp(0, __float_as_int(src), 0x122, 0xf, 0xf, false)); }
struct EpiGU {
    static constexpr bool PERM = true, AFTER_DRAIN = false;
    bf16_t* act; const float* dw; const float* db; float* halo; unsigned* flag; PG8_LAS float* E;
    template <int AI, int M>
    __device__ __forceinline__ void rows16(const f32x4 (&acc)[2][2][4][2], const float (&P1)[8], const float (&P2)[8], const float (&w0)[8], const float (&w1)[8], const float (&w2)[8], const float (&bb)[8],
                                           long row, int c, int fr) const {
        float o[8];
#pragma unroll
        for (int e = 0; e < 8; e += 2) { f32x2 g, g1, g2;
#pragma unroll
            for (int k = 0; k < 2; ++k) { const int ee = e + k; const float gv = acc[AI][0][M][ee >> 2][ee & 3];
                float s1, s2;
                if (M > 0) { const float pv = acc[AI][0][M > 0 ? M - 1 : 0][ee >> 2][ee & 3]; s1 = dpp_ror1(pv); s2 = dpp_ror2(pv); }
                else { s1 = P1[ee]; s2 = fr == 0 ? P2[ee] : P1[ee]; }
                g[k] = gv; g1[k] = dpp_shr1(s1, gv); g2[k] = dpp_shr2(s2, gv); }
            const f32x2 w0v = {w0[e], w0[e + 1]}, w1v = {w1[e], w1[e + 1]}, w2v = {w2[e], w2[e + 1]}, bv = {bb[e], bb[e + 1]};
            const f32x2 upv = {acc[AI][1][M][e >> 2][e & 3], acc[AI][1][M][(e + 1) >> 2][(e + 1) & 3]};
            const f32x2 cv = bv + w0v * g2 + w1v * g1 + w2v * g;
            const f32x2 ov = gelu_tanh2(cv) * upv; o[e] = ov.x; o[e + 1] = ov.y; }
        *(u32x4*)(act + row * DFF + c) = pack8(o);
    }
    __device__ __forceinline__ void operator()(const f32x4 (&acc)[2][2][4][2], const Unit& u, int wr, int wc, int fr, int fq) const {
        const int lc = wc * 32 + 8 * fq;
        const int c = u.pn * 128 + lc;
        if (fr >= 14) {
#pragma unroll
            for (int ai = 0; ai < 2; ++ai)
#pragma unroll
                for (int n = 0; n < 2; ++n) *(PG8_LAS f32x4*)(E + ((ai * 2 + wr) * 2 + (fr - 14)) * 128 + lc + 4 * n) = acc[ai][0][3][n];
            if (wr == 1) { float* hp = halo + ((size_t)(u.pm * 22 + u.pn) * 2 + (fr - 14)) * 128 + lc;
#pragma unroll
                for (int n = 0; n < 2; ++n)
#pragma unroll
                    for (int e = 0; e < 4; ++e) __hip_atomic_store(hp + 4 * n + e, acc[1][0][3][n][e], __ATOMIC_RELAXED, __HIP_MEMORY_SCOPE_AGENT); }
        }
        if (wr == 1) { asm volatile("s_waitcnt vmcnt(0)" ::: "memory");
            if ((fr | fq) == 0) __hip_atomic_fetch_add(flag + u.pm * 22 + u.pn, 1u, __ATOMIC_RELAXED, __HIP_MEMORY_SCOPE_AGENT); }
        float w0[8], w1[8], w2[8], bb[8];
#pragma unroll
        for (int e = 0; e < 8; ++e) { w0[e] = dw[c + e]; w1[e] = dw[DFF + c + e]; w2[e] = dw[2 * DFF + c + e]; bb[e] = db[c + e]; }
        const long rb = (long)u.pm * 256 + wr * 64 + fr;
        const float Z[8] = {0.f, 0.f, 0.f, 0.f, 0.f, 0.f, 0.f, 0.f};
        rows16<1, 1>(acc, Z, Z, w0, w1, w2, bb, rb + 128 + 16, c, fr); rows16<1, 2>(acc, Z, Z, w0, w1, w2, bb, rb + 128 + 32, c, fr); rows16<1, 3>(acc, Z, Z, w0, w1, w2, bb, rb + 128 + 48, c, fr);
        rows16<0, 1>(acc, Z, Z, w0, w1, w2, bb, rb + 16, c, fr); rows16<0, 2>(acc, Z, Z, w0, w1, w2, bb, rb + 32, c, fr); rows16<0, 3>(acc, Z, Z, w0, w1, w2, bb, rb + 48, c, fr);
        asm volatile("s_waitcnt lgkmcnt(0)" ::: "memory"); __builtin_amdgcn_s_barrier(); asm volatile("" ::: "memory");
        { float P1[8], P2[8]; const int blk = 2 + wr;
#pragma unroll
          for (int n = 0; n < 2; ++n) { const f32x4 a = *(const PG8_LAS f32x4*)(E + ((blk - 1) * 2 + 1) * 128 + lc + 4 * n), d = *(const PG8_LAS f32x4*)(E + ((blk - 1) * 2 + 0) * 128 + lc + 4 * n);
#pragma unroll
              for (int e = 0; e < 4; ++e) { P1[4 * n + e] = a[e]; P2[4 * n + e] = d[e]; } }
          rows16<1, 0>(acc, P1, P2, w0, w1, w2, bb, rb + 128, c, fr); }
        { float P1[8], P2[8];
          const bool need_halo = (wr == 0) && ((u.pm & 15) != 0);
          if (wr == 1) {
#pragma unroll
              for (int n = 0; n < 2; ++n) { const f32x4 a = *(const PG8_LAS f32x4*)(E + 1 * 128 + lc + 4 * n), d = *(const PG8_LAS f32x4*)(E + lc + 4 * n);
#pragma unroll
                  for (int e = 0; e < 4; ++e) { P1[4 * n + e] = a[e]; P2[4 * n + e] = d[e]; } }
          } else if (need_halo) { unsigned* fp = flag + (u.pm - 1) * 22 + u.pn; unsigned spins = 0;
              while ((unsigned)__builtin_amdgcn_readfirstlane(__hip_atomic_load(fp, __ATOMIC_RELAXED, __HIP_MEMORY_SCOPE_AGENT)) < 4u) { if (++spins > (1u << 22)) break; __builtin_amdgcn_s_sleep(1); }
              const float* hp = halo + ((size_t)((u.pm - 1) * 22 + u.pn) * 2) * 128 + lc;
#pragma unroll
              for (int e = 0; e < 8; ++e) { P1[e] = __hip_atomic_load(hp + 128 + e, __ATOMIC_RELAXED, __HIP_MEMORY_SCOPE_AGENT); P2[e] = __hip_atomic_load(hp + e, __ATOMIC_RELAXED, __HIP_MEMORY_SCOPE_AGENT); }
          } else {
#pragma unroll
              for (int e = 0; e < 8; ++e) { P1[e] = 0.f; P2[e] = 0.f; }
          }
          rows16<0, 0>(acc, P1, P2, w0, w1, w2, bb, rb, c, fr); }
    }
};
struct PanelSumsq {
    float* xbuf; unsigned* cnt; int panel0; float eps;
    __device__ __forceinline__ void run(const f32x4 (&v)[2][2][4][2], const Unit& u, int wr, int wc, int fr, int fq, PG8_LAS unsigned char* lds, int wid, int lane) const {
        publish(v, u, wr, wc, fr, fq, lds, wid, lane); finish(u, lds, wid, lane);
    }
    __device__ __forceinline__ void publish(const f32x4 (&v)[2][2][4][2], const Unit& u, int wr, int wc, int fr, int fq, PG8_LAS unsigned char* lds, int wid, int lane) const {
        PG8_LAS float* Pp = (PG8_LAS float*)lds;
#pragma unroll
        for (int ai = 0; ai < 2; ++ai)
#pragma unroll
            for (int m = 0; m < 4; ++m) { float q = 0.f;
#pragma unroll
                for (int bj = 0; bj < 2; ++bj)
#pragma unroll
                    for (int n = 0; n < 2; ++n) { const f32x4 x = v[ai][bj][m][n]; q += (x[0] * x[0] + x[1] * x[1]) + (x[2] * x[2] + x[3] * x[3]); }
                q += __shfl_xor(q, 16); q += __shfl_xor(q, 32);
                if (fq == 0) Pp[(ai * 128 + wr * 64 + m * 16 + fr) * 4 + wc] = q; }
        asm volatile("s_waitcnt lgkmcnt(0)" ::: "memory"); __builtin_amdgcn_s_barrier(); asm volatile("" ::: "memory");
        const int row = wid * 32 + (lane & 31); const int panel = panel0 + u.pm;
        if (lane < 32) { const float tot = (Pp[row * 4 + 0] + Pp[row * 4 + 1]) + (Pp[row * 4 + 2] + Pp[row * 4 + 3]);
            __hip_atomic_store(xbuf + ((size_t)(panel * 256 + row) * 4 + u.pn), tot, __ATOMIC_RELAXED, __HIP_MEMORY_SCOPE_AGENT); }
        asm volatile("s_waitcnt vmcnt(0)" ::: "memory");
        if (lane == 0) __hip_atomic_fetch_add(cnt + 64 * panel, 1u, __ATOMIC_RELAXED, __HIP_MEMORY_SCOPE_AGENT);
    }
    __device__ __forceinline__ void finish(const Unit& u, PG8_LAS unsigned char* lds, int wid, int lane) const {
        PG8_LAS float* S = (PG8_LAS float*)(lds + 4096);
        const int row = wid * 32 + (lane & 31); const int panel = panel0 + u.pm;
        if (wid == 0) {
            unsigned spins = 0;
            for (;;) { if ((unsigned)__builtin_amdgcn_readfirstlane(__hip_atomic_load(cnt + 64 * panel, __ATOMIC_RELAXED, __HIP_MEMORY_SCOPE_AGENT)) >= 32u) break;
                if (++spins > (1u << 22)) break;
                __builtin_amdgcn_s_sleep(2); }
            __builtin_amdgcn_fence(__ATOMIC_ACQUIRE, "agent");
        }
        asm volatile("s_waitcnt vmcnt(0) lgkmcnt(0)" ::: "memory"); __builtin_amdgcn_s_barrier(); asm volatile("" ::: "memory");
        if (lane < 32) { const float* slot = xbuf + (size_t)(panel * 256 + row) * 4; float t = 0.f;
#pragma unroll
            for (int k = 0; k < 4; ++k) t += __hip_atomic_load(slot + k, __ATOMIC_RELAXED, __HIP_MEMORY_SCOPE_AGENT);
            S[row] = __builtin_amdgcn_rsqf(t * (1.0f / 1024.0f) + eps); }
        asm volatile("s_waitcnt lgkmcnt(0)" ::: "memory"); __builtin_amdgcn_s_barrier(); asm volatile("" ::: "memory");
    }
};
struct EpiWo {
    static constexpr bool PERM = true, AFTER_DRAIN = false;
    const float* x; bf16_t* h1b; bf16_t* xn; const float* g_post; const float* g_pre; PanelSumsq st1, st2; PG8_LAS unsigned char* lds;
    __device__ __forceinline__ void operator()(f32x4 (&acc)[2][2][4][2], const Unit& u, int wr, int wc, int fr, int fq) const {
        const int wid = wr * 4 + wc, lane = fq * 16 + fr;
        const PG8_LAS float* S = (const PG8_LAS float*)(lds + 4096);
        const int col0 = u.pn * 256 + wc * 32 + 8 * fq;
        st1.publish(acc, u, wr, wc, fr, fq, lds, wid, lane);
        f32x4 X0[3][2][2];
#pragma unroll
        for (int m = 0; m < 3; ++m) { const size_t off = (size_t)(u.pm * 256 + wr * 64 + m * 16 + fr) * DM + col0;
#pragma unroll
            for (int bj = 0; bj < 2; ++bj)
#pragma unroll
                for (int n = 0; n < 2; ++n) X0[m][bj][n] = *(const f32x4*)(x + off + bj * 128 + n * 4); }
        st1.finish(u, lds, wid, lane);
#pragma unroll
        for (int ai = 0; ai < 2; ++ai)
#pragma unroll
            for (int m = 0; m < 4; ++m) { const int r = ai * 128 + wr * 64 + m * 16 + fr; const float rs = S[r]; const size_t off = (size_t)(u.pm * 256 + r) * DM + col0;
#pragma unroll
                for (int bj = 0; bj < 2; ++bj)
#pragma unroll
                    for (int n = 0; n < 2; ++n) { const f32x4 xv = (ai == 0 && m < 3) ? X0[m < 3 ? m : 0][bj][n] : *(const f32x4*)(x + off + bj * 128 + n * 4); const f32x4 g = *(const f32x4*)(g_post + col0 + bj * 128 + n * 4);
                        acc[ai][bj][m][n] = xv + acc[ai][bj][m][n] * rs * g; }
                asm volatile("" : "+v"(acc[ai][0][m][0]), "+v"(acc[ai][0][m][1]), "+v"(acc[ai][1][m][0]), "+v"(acc[ai][1][m][1]));
                if (m & 1) asm volatile("" ::: "memory"); }
        st2.publish(acc, u, wr, wc, fr, fq, lds, wid, lane);
#pragma unroll
        for (int ai = 0; ai < 2; ++ai)
#pragma unroll
            for (int m = 0; m < 4; ++m) { const size_t off = (size_t)(u.pm * 256 + ai * 128 + wr * 64 + m * 16 + fr) * DM + col0;
#pragma unroll
                for (int bj = 0; bj < 2; ++bj) { const f32x4 h0 = acc[ai][bj][m][0], h1 = acc[ai][bj][m][1];
                    u32x4 hw; hw.x = pk2(h0[0], h0[1]); hw.y = pk2(h0[2], h0[3]); hw.z = pk2(h1[0], h1[1]); hw.w = pk2(h1[2], h1[3]); __builtin_nontemporal_store(hw, (u32x4*)(h1b + off + bj * 128)); } }
        st2.finish(u, lds, wid, lane);
#pragma unroll
        for (int ai = 0; ai < 2; ++ai)
#pragma unroll
            for (int m = 0; m < 4; ++m) { const int r = ai * 128 + wr * 64 + m * 16 + fr; const float rs = S[r]; const size_t off = (size_t)(u.pm * 256 + r) * DM + col0;
#pragma unroll
                for (int bj = 0; bj < 2; ++bj) { const f32x4 h0 = acc[ai][bj][m][0], h1 = acc[ai][bj][m][1];
                    const f32x4 g0 = *(const f32x4*)(g_pre + col0 + bj * 128), g1 = *(const f32x4*)(g_pre + col0 + bj * 128 + 4); const f32x4 o0 = h0 * rs * g0, o1 = h1 * rs * g1;
                    u32x4 w; w.x = pk2(o0[0], o0[1]); w.y = pk2(o0[2], o0[3]); w.z = pk2(o1[0], o1[1]); w.w = pk2(o1[2], o1[3]); *(u32x4*)(xn + off + bj * 128) = w; }
                asm volatile("" ::: "memory"); }
    }
};
struct EpiDown {
    static constexpr bool PERM = true, AFTER_DRAIN = false;
    const bf16_t* res; bf16_t* xn; const float* g; PanelSumsq st; PG8_LAS unsigned char* lds;
    __device__ __forceinline__ void operator()(f32x4 (&acc)[2][2][4][2], const Unit& u, int wr, int wc, int fr, int fq) const {
        const int wid = wr * 4 + wc, lane = fq * 16 + fr;
        const PG8_LAS float* S = (const PG8_LAS float*)(lds + 4096);
        const int col0 = u.pn * 256 + wc * 32 + 8 * fq;
        st.publish(acc, u, wr, wc, fr, fq, lds, wid, lane);
        u32x4 R[2][4][2];
#pragma unroll
        for (int ai = 0; ai < 2; ++ai)
#pragma unroll
            for (int m = 0; m < 4; ++m) { const size_t off = (size_t)(u.pm * 256 + ai * 128 + wr * 64 + m * 16 + fr) * DM + col0;
#pragma unroll
                for (int bj = 0; bj < 2; ++bj) R[ai][m][bj] = *(const u32x4*)(res + off + bj * 128); }
        st.finish(u, lds, wid, lane);
#pragma unroll
        for (int ai = 0; ai < 2; ++ai)
#pragma unroll
            for (int m = 0; m < 4; ++m) { const int r = ai * 128 + wr * 64 + m * 16 + fr; const float rs = S[r]; const size_t off = (size_t)(u.pm * 256 + r) * DM + col0;
#pragma unroll
                for (int bj = 0; bj < 2; ++bj) { const f32x4 g0 = *(const f32x4*)(g + col0 + bj * 128), g1 = *(const f32x4*)(g + col0 + bj * 128 + 4);
                    float hv[8]; unpack8(R[ai][m][bj], hv);
                    const f32x4 a0 = acc[ai][bj][m][0] * rs * g0, a1 = acc[ai][bj][m][1] * rs * g1; float o[8];
#pragma unroll
                    for (int e = 0; e < 4; ++e) { o[e] = hv[e] + a0[e]; o[4 + e] = hv[4 + e] + a1[e]; }
                    *(u32x4*)(xn + off + bj * 128) = pack8(o); } }
    }
};
struct EpiPe {
    static constexpr bool PERM = true, AFTER_DRAIN = false;
    bf16_t* O; float* rowss;
    __device__ __forceinline__ void operator()(const f32x4 (&acc)[2][2][4][2], const Unit& u, int wr, int wc, int fr, int fq) const {
        const int row0 = u.pm * 256 + wr * 64 + fr, c0 = u.pn * 256 + wc * 32 + 8 * fq;
#pragma unroll
        for (int ai = 0; ai < 2; ++ai)
#pragma unroll
            for (int m = 0; m < 4; ++m) { const int row = row0 + ai * 128 + m * 16; float q = 0.f;
#pragma unroll
                for (int bj = 0; bj < 2; ++bj) { const f32x4 v0 = acc[ai][bj][m][0], v1 = acc[ai][bj][m][1]; u32x4 w;
                    q += (v0[0] * v0[0] + v0[1] * v0[1]) + (v0[2] * v0[2] + v0[3] * v0[3]) + (v1[0] * v1[0] + v1[1] * v1[1]) + (v1[2] * v1[2] + v1[3] * v1[3]);
                    w.x = pk2(v0[0], v0[1]); w.y = pk2(v0[2], v0[3]); w.z = pk2(v1[0], v1[1]); w.w = pk2(v1[2], v1[3]);
                    __builtin_nontemporal_store(w, (u32x4*)(O + (long)row * DM + c0 + bj * 128)); }
                q += __shfl_xor(q, 16); q += __shfl_xor(q, 32);
                if (fq == 0) atomicAdd(rowss + row, q); }
    }
};
struct EpiOut {
    static constexpr bool PERM = true, AFTER_DRAIN = false;
    float* out; const bf16_t* h2b; const bf16_t* pe; const float* rowss; const float* gple;
    __device__ __forceinline__ void operator()(const f32x4 (&acc)[2][2][4][2], const Unit& u, int wr, int wc, int fr, int fq) const {
        const int row0 = u.pm * 256 + wr * 64 + fr, c0 = u.pn * 256 + wc * 32 + 8 * fq;
#pragma unroll
        for (int bj = 0; bj < 2; ++bj) { const int c = c0 + bj * 128;
            const f32x4 ga = *(const f32x4*)(gple + c), gb = *(const f32x4*)(gple + c + 4);
#pragma unroll
            for (int ai = 0; ai < 2; ++ai) {
            u32x4 H[4], Q[4]; float R[4];
#pragma unroll
            for (int m = 0; m < 4; ++m) { const int row = row0 + ai * 128 + m * 16;
                H[m] = *(const u32x4*)(h2b + (long)row * DM + c); Q[m] = *(const u32x4*)(pe + (long)row * DM + c); R[m] = rowss[row]; }
            __builtin_amdgcn_sched_barrier(0);
#pragma unroll
            for (int m = 0; m < 4; ++m) { const int row = row0 + ai * 128 + m * 16; const float r = __builtin_amdgcn_rsqf(R[m] * (1.0f / DM) + EPS);
                float hv[8], pv[8]; unpack8(H[m], hv); unpack8(Q[m], pv);
                const f32x4 v0 = acc[ai][bj][m][0], v1 = acc[ai][bj][m][1]; f32x4 o0, o1;
#pragma unroll
                for (int e = 0; e < 4; e += 2) { const f32x2 s0 = fast_sigmoid2((f32x2){v0[e], v0[e + 1]}), s1 = fast_sigmoid2((f32x2){v1[e], v1[e + 1]});
                    const f32x2 e0 = (f32x2){pv[e], pv[e + 1]} * r * (f32x2){ga[e], ga[e + 1]}, e1 = (f32x2){pv[4 + e], pv[5 + e]} * r * (f32x2){gb[e], gb[e + 1]};
                    const f32x2 q0 = (f32x2){hv[e], hv[e + 1]} + s0 * e0, q1 = (f32x2){hv[4 + e], hv[5 + e]} + s1 * e1;
                    o0[e] = q0.x; o0[e + 1] = q0.y; o1[e] = q1.x; o1[e + 1] = q1.y; }
                float* op = out + (long)row * DM + c; *(f32x4*)op = o0; *(f32x4*)(op + 4) = o1; } } }
    }
};
template <class Epi>
__device__ __forceinline__ void run_gemm_fused(LAS unsigned char* lds, const bf16_t* A, const bf16_t* Bt, int K, int G, int c, const Epi& E) {
    pg8::Gemm g{A, Bt, 16384, DM, K}; pg8::StaticOrder S; S.init(16384, DM, G, c);
    pg8::gemm_phase<Epi, pg8::StaticOrder, false, true>(lds, g, S, E);
    __syncthreads();
}

template <class Epi>
__device__ __forceinline__ void run_gemm(LAS unsigned char* lds, const bf16_t* A, const bf16_t* Bt, int M, int N, int K, int G, int c, const Epi& E) {
    pg8::Gemm g{A, Bt, M, N, K}; pg8::StaticOrder S; S.init(M, N, G, c);
    pg8::gemm_phase<Epi, pg8::StaticOrder, true, true>(lds, g, S, E);
    __syncthreads();
}

__device__ __forceinline__ int src_col(int mode, int n) {
    if (mode == 1) { const int h = n / 96, w = n % 96; if (w < 64) return n; const int j = w - 64; return h * 96 + 64 + 16 * (j & 1) + (j >> 1); }
    if (mode == 2) return (n >> 6) * 128 + (n & 63);
    if (mode == 3) return (n >> 6) * 128 + 64 + (n & 63);
    if (mode == 4) return (n >> 8) * 128 + (n & 127);
    if (mode == 5) { if (n < 672) return n; if (n < 768) return -1; const int e = n - 768, k = e >> 8, w = e & 255; return 672 + (w >= 128 ? 512 : 0) + 128 * k + (w & 127); }
    return n;
}
__device__ __forceinline__ void transpose_item(const float* W, int K, int Nsrc, int Ndst, bf16_t* WT, LAS float* scr, int item, int lane, int mode, float mul = 1.0f) {
    const int nblk = Ndst / 32, kb = item / nblk, nb = item % nblk, k0 = 64 * kb, n0 = 32 * nb;
    const int sc = src_col(mode, n0 + (lane & 31));
    float tv[32];
#pragma unroll
    for (int i = 0; i < 32; ++i) { const int kk = 2 * i + (lane >> 5); tv[i] = sc >= 0 ? __builtin_nontemporal_load(W + (size_t)(k0 + kk) * Nsrc + sc) : 0.f; }
#pragma unroll
    for (int i = 0; i < 32; ++i) { const int kk = 2 * i + (lane >> 5); scr[kk * 33 + (lane & 31)] = tv[i] * mul; }
    asm volatile("s_waitcnt lgkmcnt(0)" ::: "memory");
    const int c = lane & 7;
#pragma unroll
    for (int j = 0; j < 4; ++j) { const int n = (lane >> 3) + 8 * j; const LAS float* s = scr + (8 * c) * 33 + n;
        u32x4 o; o.x = pk2(s[0 * 33], s[1 * 33]); o.y = pk2(s[2 * 33], s[3 * 33]); o.z = pk2(s[4 * 33], s[5 * 33]); o.w = pk2(s[6 * 33], s[7 * 33]);
        *(u32x4*)(WT + (size_t)(n0 + n) * K + k0 + 8 * c) = o; }
    asm volatile("s_waitcnt lgkmcnt(0)" ::: "memory");
}
__device__ __forceinline__ void load_row_f32(const float* rp, int lane, float (&v)[16]) {
#pragma unroll
    for (int j = 0; j < 2; ++j) { const f32x4 a = *(const f32x4*)(rp + 512 * j + 8 * lane), b = *(const f32x4*)(rp + 512 * j + 8 * lane + 4);
#pragma unroll
        for (int e = 0; e < 4; ++e) { v[8 * j + e] = a[e]; v[8 * j + 4 + e] = b[e]; } }
}
__device__ __forceinline__ void load_row_bf16(const bf16_t* rp, int lane, float (&v)[16]) {
#pragma unroll
    for (int j = 0; j < 2; ++j) { const u32x4 w = *(const u32x4*)(rp + 512 * j + 8 * lane); float f[8]; unpack8(w, f);
#pragma unroll
        for (int e = 0; e < 8; ++e) v[8 * j + e] = f[e]; }
}
__device__ __forceinline__ void store_row_bf16(bf16_t* rp, int lane, const float (&v)[16]) {
#pragma unroll
    for (int j = 0; j < 2; ++j) { float f[8];
#pragma unroll
        for (int e = 0; e < 8; ++e) f[e] = v[8 * j + e];
        *(u32x4*)(rp + 512 * j + 8 * lane) = pack8(f); }
}
__device__ __forceinline__ void store_row_f32(float* rp, int lane, const float (&v)[16]) {
#pragma unroll
    for (int j = 0; j < 2; ++j) { f32x4 a, b;
#pragma unroll
        for (int e = 0; e < 4; ++e) { a[e] = v[8 * j + e]; b[e] = v[8 * j + 4 + e]; }
        *(f32x4*)(rp + 512 * j + 8 * lane) = a; *(f32x4*)(rp + 512 * j + 8 * lane + 4) = b; }
}
__device__ __forceinline__ float sumsq16(const float (&v)[16]) { float s = 0.f;
#pragma unroll
    for (int e = 0; e < 16; ++e) s += v[e] * v[e];
    return s; }

__device__ __forceinline__ void phase_prologue(const Params& P, LAS unsigned char* lds, int vcu, int G, int wave, int lane) {
    unsigned char* ws = P.ws;
    LAS float* scr = (LAS float*)(lds + wave * 16384);
    const int gw = vcu * 8 + wave, NGW = G * 8;
    const int gt = gw * 64 + lane, NGT = NGW * 64;
    const int gw4 = vcu * 4 + (wave & 3), NGW4 = G * 4, gt4 = gw4 * 64 + lane, NGT4 = NGW4 * 64;
    if (wave >= 4) {
    constexpr int I0 = 16 * 56, I1 = 6 * 24, I2 = 4 * 16, I3 = 4 * 16, I4 = 16 * 32, I5 = 16 * 176, I6 = 0, I7 = 44 * 32, I8 = 4 * 32, I9 = 16 * 32;
    constexpr int NITEMS = I0 + I1 + I2 + I3 + I4 + I5 + I6 + I7 + I8 + I9;
    for (int it = gw4; it < NITEMS; it += NGW4) {
        int r = it;
        if (r < I0) { transpose_item(P.w_in, DM, NPROJ, NPROJ_P, (bf16_t*)(ws + WS_WIN), scr, r, lane, 5); continue; } r -= I0;
        if (r < I1) { transpose_item(P.w_q_b, QL, NQ, NQ, (bf16_t*)(ws + WS_WQ), scr, r, lane, 1, QSCALE); continue; } r -= I1;
        if (r < I2) { transpose_item(P.w_kv_b, KVL, 1024, 512, (bf16_t*)(ws + WS_WK), scr, r, lane, 2); continue; } r -= I2;
        if (r < I3) { transpose_item(P.w_kv_b, KVL, 1024, 512, (bf16_t*)(ws + WS_WV), scr, r, lane, 3); continue; } r -= I3;
        if (r < I4) { transpose_item(P.w_o, DM, DM, DM, (bf16_t*)(ws + WS_WO), scr, r, lane, 0); continue; } r -= I4;
        if (r < I5) { const int nb = r % 176; transpose_item((nb & 4) ? P.w_up : P.w_gate, DM, DFF, 2 * DFF, (bf16_t*)(ws + WS_WG), scr, r, lane, 4); continue; } r -= I5;
        if (r < I7) { transpose_item(P.w_down, DFF, DM, DM, (bf16_t*)(ws + WS_WD), scr, r, lane, 0); continue; } r -= I7;
        if (r < I8) { transpose_item(P.w_ple_proj, PLE, DM, DM, (bf16_t*)(ws + WS_WPP), scr, r, lane, 0); continue; } r -= I8;
        transpose_item(P.w_ple_gate, DM, DM, DM, (bf16_t*)(ws + WS_WPG), scr, r, lane, 0);
    }
    { float* cs = (float*)(ws + WS_CS);
      for (int i = gt4; i < TT * 16; i += NGT4) { const int t = i >> 4, k = i & 15;
          const float inv = exp2f(-(float)k * (13.287712379549449f / 16.0f));
          const float ang = (float)P.pos[t] * inv;
          const double rev = (double)ang * 0.15915494309189535; const float fr = (float)(rev - floor(rev));
          cs[2 * (size_t)i] = __builtin_amdgcn_cosf(fr); cs[2 * (size_t)i + 1] = __builtin_amdgcn_sinf(fr); } }
    }
    { constexpr int XN_SPLIT = 27648; const int lo = wave < 4 ? 0 : XN_SPLIT, hi_ = wave < 4 ? XN_SPLIT : TT;
      f32x4 g[4];
#pragma unroll
      for (int j = 0; j < 4; ++j) g[j] = *(const f32x4*)(P.g_mix_pre + 4 * lane + 256 * j);
      bf16_t* XB = (bf16_t*)(ws + WS_XB);
      for (int m = lo + gw4; m < hi_; m += 4 * NGW4) { f32x4 v[4][4];
#pragma unroll
          for (int u = 0; u < 4; ++u) { const int mm = m + u * NGW4 < hi_ ? m + u * NGW4 : m;
#pragma unroll
              for (int j = 0; j < 4; ++j) v[u][j] = __builtin_nontemporal_load((const f32x4*)(P.x + (size_t)mm * DM + 4 * lane + 256 * j)); }
#pragma unroll
          for (int u = 0; u < 4; ++u) { const int mm = m + u * NGW4; float ss = 0.f;
#pragma unroll
              for (int j = 0; j < 4; ++j) ss += (v[u][j][0] * v[u][j][0] + v[u][j][1] * v[u][j][1]) + (v[u][j][2] * v[u][j][2] + v[u][j][3] * v[u][j][3]);
              const float rstd = __builtin_amdgcn_rsqf(wave_sum(ss) * (1.0f / DM) + EPS);
              if (mm < hi_) {
#pragma unroll
                  for (int j = 0; j < 4; ++j) { const f32x4 o = v[u][j] * rstd * g[j]; u32x2 w; w.x = pk2(o[0], o[1]); w.y = pk2(o[2], o[3]);
                      *(u32x2*)(XB + (size_t)mm * DM + 4 * lane + 256 * j) = w; } } } } }
    { const f32x4* pp = (const f32x4*)P.p; u32x2* pb = (u32x2*)(ws + WS_PBF); constexpr int NCH = TT * PLE / 4;
      for (int i = gt; i < NCH; i += 4 * NGT) { f32x4 a[4];
#pragma unroll
          for (int u = 0; u < 4; ++u) a[u] = __builtin_nontemporal_load(pp + (i + u * NGT < NCH ? i + u * NGT : i));
#pragma unroll
          for (int u = 0; u < 4; ++u) if (i + u * NGT < NCH) { u32x2 o; o.x = pk2(a[u][0], a[u][1]); o.y = pk2(a[u][2], a[u][3]); pb[i + u * NGT] = o; } } }
}

__device__ __forceinline__ void phase_r1(const Params& P, LAS unsigned char* lds, int vcu, int G, int tid, int wave, int lane) {
    unsigned char* ws = P.ws;
    const bf16_t* proj = (const bf16_t*)(ws + WS_PROJ);
    bf16_t* qan = (bf16_t*)(ws + WS_QAN); bf16_t* kvan = (bf16_t*)(ws + WS_KVAN); bf16_t* Kb = (bf16_t*)(ws + WS_K); bf16_t* cat = (bf16_t*)(ws + WS_CAT);
    const float* cs = (const float*)(ws + WS_CS);
    LAS float* cbuf = (LAS float*)lds;
    for (int ch = vcu; ch < TT / 128; ch += G) {
        const int t0 = ch * 128;
        { const bool has_halo = (t0 & (SEQ - 1)) != 0;
#define R1_BAR() do { asm volatile("s_waitcnt lgkmcnt(0)" ::: "memory"); __builtin_amdgcn_s_barrier(); asm volatile("" ::: "memory"); } while (0)
          if (wave < 4) {
              const int tc = tid;
              f32x2 w2[CONVW];
              { const float* wp = P.conv_w + 2 * tc;
#pragma unroll
                for (int j = 0; j < CONVW; ++j) { w2[j] = *(const f32x2*)wp; wp += CONVC; asm volatile("" : "+v"(wp)); } }
              const f32x2 bias2 = *(const f32x2*)(P.conv_b + 2 * tc);
              const unsigned* pg = (const unsigned*)((const bf16_t*)(ws + WS_GLU) + 2 * tc);
              f32x2 win[38];
              { unsigned hv[30];
#pragma unroll
                for (int j = 0; j < 30; ++j) hv[j] = pg[(size_t)(has_halo ? t0 - 30 + j : t0) * (CONVC / 2)];
#pragma unroll
                for (int j = 0; j < 30; ++j) win[j] = has_halo ? (f32x2){bf_lo(hv[j]), bf_hi(hv[j])} : (f32x2){0.f, 0.f}; }
              unsigned nv[4][8];
#pragma unroll
              for (int q = 0; q < 4; ++q)
#pragma unroll
                  for (int u = 0; u < 8; ++u) nv[q][u] = pg[(size_t)(t0 + 8 * q + u) * (CONVC / 2)];
#define R1_STEP(g, sl) do { const int tg = t0 + 8 * (g); \
                  _Pragma("unroll") for (int u = 0; u < 8; ++u) win[30 + u] = (f32x2){bf_lo(nv[sl][u]), bf_hi(nv[sl][u])}; \
                  if ((g) + 4 < 16) { _Pragma("unroll") for (int u = 0; u < 8; ++u) nv[sl][u] = pg[(size_t)(tg + 32 + u) * (CONVC / 2)]; } \
                  LAS float* cb = cbuf + ((g) & 1) * 4096; \
                  _Pragma("unroll") for (int u = 0; u < 8; u += 2) { f32x2 a2 = bias2, b2 = bias2; \
                      _Pragma("unroll") for (int j = 0; j < CONVW; ++j) { a2 += w2[j] * win[u + j]; b2 += w2[j] * win[u + 1 + j]; } \
                      *(LAS f32x2*)(cb + u * 512 + 2 * tc) = a2; *(LAS f32x2*)(cb + (u + 1) * 512 + 2 * tc) = b2; __builtin_amdgcn_sched_barrier(0); } \
                  _Pragma("unroll") for (int j = 0; j < 30; ++j) win[j] = win[j + 8]; \
                  R1_BAR(); } while (0)
              for (int gb = 0; gb < 16; gb += 4) { R1_STEP(gb, 0); R1_STEP(gb + 1, 1); R1_STEP(gb + 2, 2); R1_STEP(gb + 3, 3); }
#undef R1_STEP
              R1_BAR();
          } else {
              float lg[8], lb[8], gq[8], gk[8];
#pragma unroll
              for (int e = 0; e < 8; ++e) { lg[e] = P.conv_ln_g[8 * lane + e]; lb[e] = P.conv_ln_b[8 * lane + e]; gq[e] = lane < 48 ? P.g_q_a[8 * lane + e] : 0.f; gk[e] = lane < 32 ? P.g_kv_a[8 * lane + e] : 0.f; }
              const int tb = t0 + (wave - 4) * 32;
              u32x4 bq[4][2], bk[4][2]; bf16_t b1[4][2], b2[4][2]; float bc[4][2], bs[4][2];
#define R1_BLOAD(sl, g) do { _Pragma("unroll") for (int k = 0; k < 2; ++k) { const int t = tb + 2 * (g) + k; const bf16_t* pr = proj + (size_t)t * PROJ_LD; const u32x4 z = {0u, 0u, 0u, 0u}; \
                      bq[sl][k] = lane < 48 ? *(const u32x4*)(pr + 8 * lane) : z; bk[sl][k] = lane < 32 ? *(const u32x4*)(pr + QL + 8 * lane) : z; \
                      b1[sl][k] = lane < 16 ? pr[QL + KVL + lane] : (bf16_t)0; b2[sl][k] = lane < 16 ? pr[QL + KVL + 16 + lane] : (bf16_t)0; \
                      bc[sl][k] = lane < 16 ? cs[((size_t)t * 16 + lane) * 2] : 0.f; bs[sl][k] = lane < 16 ? cs[((size_t)t * 16 + lane) * 2 + 1] : 0.f; } } while (0)
#define R1_BCOMP(sl, g) do { _Pragma("unroll") for (int k = 0; k < 2; ++k) { const int t = tb + 2 * (g) + k; \
                      float fq[8], fk[8]; unpack8(bq[sl][k], fq); unpack8(bk[sl][k], fk); float sq = 0.f, sk = 0.f; \
                      _Pragma("unroll") for (int e = 0; e < 8; ++e) { sq += fq[e] * fq[e]; sk += fk[e] * fk[e]; } \
                      const float rq = __builtin_amdgcn_rsqf(wave_sum(sq) * (1.0f / QL) + EPS), rk = __builtin_amdgcn_rsqf(wave_sum(sk) * (1.0f / KVL) + EPS); \
                      _Pragma("unroll") for (int e = 0; e < 8; ++e) { fq[e] = fq[e] * rq * gq[e]; fk[e] = fk[e] * rk * gk[e]; } \
                      if (lane < 48) *(u32x4*)(qan + (size_t)t * QL + 8 * lane) = pack8(fq); \
                      if (lane < 32) *(u32x4*)(kvan + (size_t)t * KVL + 8 * lane) = pack8(fk); \
                      { const float x1 = bf1(b1[sl][k]), x2 = bf1(b2[sl][k]); const unsigned o = pk2(x1 * bc[sl][k] - x2 * bs[sl][k], x1 * bs[sl][k] + x2 * bc[sl][k]); \
                        const int sh = 4 * (lane & 3); u32x4 kv4; \
                        kv4.x = (unsigned)__shfl((int)o, sh); kv4.y = (unsigned)__shfl((int)o, sh + 1); kv4.z = (unsigned)__shfl((int)o, sh + 2); kv4.w = (unsigned)__shfl((int)o, sh + 3); \
                        if (lane < 32) *(u32x4*)(Kb + (size_t)t * NQ + (lane >> 2) * 96 + 64 + 2 * sh) = kv4; } } } while (0)
#define R1_LN(gp) do { const LAS float* cb = cbuf + ((gp) & 1) * 4096; \
                  _Pragma("unroll") for (int k = 0; k < 2; ++k) { const int u = (wave - 4) * 2 + k; \
                      const LAS f32x4* rp = (const LAS f32x4*)(cb + u * 512 + 8 * lane); const f32x4 a = rp[0], b4 = rp[1]; float v[8]; \
                      _Pragma("unroll") for (int e = 0; e < 4; ++e) { v[e] = a[e]; v[4 + e] = b4[e]; } \
                      float sm = 0.f; _Pragma("unroll") for (int e = 0; e < 8; ++e) sm += v[e]; \
                      const float mean = wave_sum(sm) * (1.0f / CONVC); float q = 0.f; \
                      _Pragma("unroll") for (int e = 0; e < 8; ++e) { v[e] -= mean; q += v[e] * v[e]; } \
                      const float rstd = __builtin_amdgcn_rsqf(wave_sum(q) * (1.0f / CONVC) + EPS); \
                      _Pragma("unroll") for (int e = 0; e < 8; ++e) { const float y = v[e] * rstd * lg[e] + lb[e]; v[e] = y * fast_sigmoid(y); } \
                      *(u32x4*)(cat + (size_t)(t0 + 8 * (gp) + u) * DM + 512 + 8 * lane) = pack8(v); } } while (0)
#define R1_LSTEP(g, sl) do { if ((g) >= 1) R1_LN((g) - 1); R1_BCOMP(sl, g); if ((g) + 4 < 16) R1_BLOAD(sl, (g) + 4); R1_BAR(); } while (0)
              R1_BLOAD(0, 0); R1_BLOAD(1, 1); R1_BLOAD(2, 2); R1_BLOAD(3, 3);
              for (int gb = 0; gb < 16; gb += 4) { R1_LSTEP(gb, 0); R1_LSTEP(gb + 1, 1); R1_LSTEP(gb + 2, 2); R1_LSTEP(gb + 3, 3); }
              R1_LN(15); R1_BAR();
#undef R1_LSTEP
#undef R1_LN
#undef R1_BCOMP
#undef R1_BLOAD
          }
#undef R1_BAR
          __syncthreads();
        }
    }
}

constexpr int KROW = 208, VROW = 144, KBUF = 64 * KROW, VBUF = 64 * VROW, ABUF = KBUF + VBUF;
constexpr float ATT_THR = 8.0f;
__device__ __forceinline__ int crow(int r, int hi) { return (r & 3) + 8 * (r >> 2) + 4 * hi; }
__device__ __forceinline__ float max3f(float a, float b, float c) { return fmaxf(fmaxf(a, b), c); }
template <bool PRE>
__device__ __forceinline__ float attn_half(f32x16& c, const f32x16& b, f32x16& n, f32x16& o0, f32x16& o1, float& lsum, const LAS unsigned char* kn, const LAS unsigned char* kn2, const LAS unsigned char* vb,
                                           const bf16x8 (&qr)[6], const f32x16& negm, bf16x8& f0, bf16x8& f1) {
    float ps = 0.f, mxb;
    bf16x8 f2, va0, va1, vb0, vb1;
#define ATT_EXP(r) do { c[r] = __builtin_amdgcn_exp2f(c[r]); ps += c[r]; } while (0)
#define ATT_KRD(dst, d0) do { dst = *(const LAS bf16x8*)(kn + (d0) * 32); } while (0)
#define ATT_QKC(src, d0) do { n = __builtin_amdgcn_mfma_f32_32x32x16_bf16(src, qr[d0], (d0) == 0 ? negm : n, 0, 0, 0); } while (0)
#define ATT_FENCE() __builtin_amdgcn_sched_barrier(0)
    ATT_KRD(f2, 2); ATT_FENCE(); ATT_QKC(f0, 0); ATT_EXP(0); ATT_EXP(1); ATT_EXP(2); mxb = max3f(b[0], b[1], b[2]); mxb = max3f(mxb, b[3], b[4]); ATT_FENCE();
    ATT_KRD(f0, 3); ATT_FENCE(); ATT_QKC(f1, 1); ATT_EXP(3); ATT_EXP(4); ATT_EXP(5); mxb = max3f(mxb, b[5], b[6]); mxb = max3f(mxb, b[7], b[8]); ATT_FENCE();
    ATT_KRD(f1, 4); ATT_FENCE(); ATT_QKC(f2, 2); ATT_EXP(6); ATT_EXP(7); ATT_EXP(8); mxb = max3f(mxb, b[9], b[10]); ATT_FENCE();
    ATT_KRD(f2, 5); va0 = *(const LAS bf16x8*)(vb); va1 = *(const LAS bf16x8*)(vb + 32 * VROW); ATT_FENCE(); ATT_QKC(f0, 3); ATT_EXP(9); ATT_EXP(10); ATT_EXP(11); mxb = max3f(mxb, b[11], b[12]); ATT_FENCE();
    vb0 = *(const LAS bf16x8*)(vb + 32); vb1 = *(const LAS bf16x8*)(vb + 32 * VROW + 32); if (PRE) f0 = *(const LAS bf16x8*)(kn2); ATT_FENCE(); ATT_QKC(f1, 4); ATT_EXP(12); ATT_EXP(13); mxb = max3f(mxb, b[13], b[14]); ATT_FENCE();
    if (PRE) f1 = *(const LAS bf16x8*)(kn2 + 32); ATT_FENCE(); ATT_QKC(f2, 5); ATT_EXP(14); ATT_EXP(15); mxb = fmaxf(mxb, b[15]); ATT_FENCE();
#undef ATT_EXP
#undef ATT_KRD
#undef ATT_QKC
    lsum += ps;
    const float mxo = __shfl_xor(mxb, 32);
    { u32x4 pw; pw.x = pk2(c[0], c[1]); pw.y = pk2(c[2], c[3]); pw.z = pk2(c[4], c[5]); pw.w = pk2(c[6], c[7]); const bf16x8 pb = __builtin_bit_cast(bf16x8, pw);
      o0 = __builtin_amdgcn_mfma_f32_32x32x16_bf16(va0, pb, o0, 0, 0, 0); o1 = __builtin_amdgcn_mfma_f32_32x32x16_bf16(va1, pb, o1, 0, 0, 0); ATT_FENCE(); }
    { u32x4 pw; pw.x = pk2(c[8], c[9]); pw.y = pk2(c[10], c[11]); pw.z = pk2(c[12], c[13]); pw.w = pk2(c[14], c[15]); const bf16x8 pb = __builtin_bit_cast(bf16x8, pw);
      o0 = __builtin_amdgcn_mfma_f32_32x32x16_bf16(vb0, pb, o0, 0, 0, 0); o1 = __builtin_amdgcn_mfma_f32_32x32x16_bf16(vb1, pb, o1, 0, 0, 0); ATT_FENCE(); }
#undef ATT_FENCE
    return fmaxf(mxb, mxo);
}
__device__ __forceinline__ void attn_unit(int b, int h, int qb, const bf16_t* Q, const bf16_t* K, const bf16_t* Vt, const float* cs, bf16_t* O, LAS unsigned char* lds, int tid, int wid, int lane) {
    const int r32 = lane & 31, hi = lane >> 5;
    const int q0 = qb * 256, qrow = q0 + wid * 32 + r32; const long tok = (long)b * SEQ + qrow;
    bf16x8 qr[6];
#pragma unroll
    for (int d0 = 0; d0 < 6; ++d0) qr[d0] = *(const bf16x8*)(Q + tok * NQ + h * 96 + d0 * 16 + hi * 8);
#pragma unroll
    for (int d0 = 4; d0 < 6; ++d0) { const int i0 = 8 * (d0 - 4) + 4 * hi; const f32x4* tp = (const f32x4*)(cs + (tok * 16 + i0) * 2); const f32x4 a = tp[0], c = tp[1];
        float f[8]; unpack8(__builtin_bit_cast(u32x4, qr[d0]), f); float g[8];
        g[0] = f[0] * a[0] - f[1] * a[1]; g[1] = f[0] * a[1] + f[1] * a[0]; g[2] = f[2] * a[2] - f[3] * a[3]; g[3] = f[2] * a[3] + f[3] * a[2];
        g[4] = f[4] * c[0] - f[5] * c[1]; g[5] = f[4] * c[1] + f[5] * c[0]; g[6] = f[6] * c[2] - f[7] * c[3]; g[7] = f[6] * c[3] + f[7] * c[2];
        qr[d0] = __builtin_bit_cast(bf16x8, pack8(g)); }
    const bf16_t* Kh = K + (long)b * SEQ * NQ + h * 96;
    const bf16_t* Vh = Vt + ((long)b * 512 + h * 64) * SEQ;
    const int kr0 = tid / 12, kc0 = tid % 12, kr1 = (tid + 512) / 12, kc1 = (tid + 512) % 12; const bool k1 = tid < 256;
    const int vr = tid >> 3, vc = tid & 7;
    unsigned kvo0 = (unsigned)(kr0 * NQ + kc0 * 8) * 2u, kvo1 = (unsigned)(kr1 * NQ + kc1 * 8) * 2u, vvo = (unsigned)(vr * SEQ + vc * 8) * 2u;
    unsigned ksto0 = (unsigned)(kr0 * KROW + kc0 * 16), ksto1 = (unsigned)(kr1 * KROW + kc1 * 16), vsto = (unsigned)(KBUF + vr * VROW + (vc >> 1) * 32 + (vc & 1) * 8);
    unsigned kbase = (unsigned)(r32 * KROW + hi * 16), vbase = (unsigned)(KBUF + r32 * VROW + hi * 16);
    asm volatile("" : "+v"(kvo0), "+v"(kvo1), "+v"(vvo), "+v"(ksto0), "+v"(ksto1), "+v"(vsto), "+v"(kbase), "+v"(vbase));
    const int NT = 4 * (qb + 1);
    u32x4 sk0, sk1 = {0u, 0u, 0u, 0u}, sv;
#define ATT_LOAD(t) do { const char* kt_ = (const char*)(Kh + (long)(64 * (t)) * NQ); const char* vt_ = (const char*)(Vh + 64 * (t)); \
        sk0 = *(const u32x4*)(kt_ + kvo0); if (k1) sk1 = *(const u32x4*)(kt_ + kvo1); sv = *(const u32x4*)(vt_ + vvo); } while (0)
#define ATT_STORE(boff) do { LAS unsigned char* kb_ = lds + (boff); *(LAS u32x4*)(kb_ + ksto0) = sk0; if (k1) *(LAS u32x4*)(kb_ + ksto1) = sk1; \
        { LAS unsigned char* vp_ = kb_ + vsto; u32x2 lo_ = {sv.x, sv.y}, hi_ = {sv.z, sv.w}; *(LAS u32x2*)vp_ = lo_; *(LAS u32x2*)(vp_ + 16) = hi_; } } while (0)
    ATT_LOAD(0); ATT_STORE(0);
    ATT_LOAD(1); ATT_STORE(ABUF);
    __syncthreads();
    f32x16 o0 = {}, o1 = {};
    float m_ref = 0.f, lsum = 0.f;
    const int wq_lo = q0 + wid * 32, wq_hi = wq_lo + 31;
    f32x16 pa, pb, pc, negm = {};
#define ATT_DECIDE(mx, X, Y) do { if (__any((mx) > ATT_THR)) { \
            const float d_ = fmaxf((mx), 0.f); const float alpha = __builtin_amdgcn_exp2f(-d_); m_ref += d_; lsum *= alpha; \
            _Pragma("unroll") for (int r = 0; r < 16; ++r) { o0[r] *= alpha; o1[r] *= alpha; X[r] -= d_; Y[r] -= d_; negm[r] = -m_ref; } } } while (0)
#define ATT_MASK(X, hs) do { if (32 * (hs) + 31 > wq_lo) { const int kv0 = 32 * (hs); \
            _Pragma("unroll") for (int r = 0; r < 16; ++r) { if (kv0 + crow(r, hi) > qrow) X[r] = -INFINITY; } } } while (0)
    { const f32x16 zero = {};
#pragma unroll
      for (int d0 = 0; d0 < 6; ++d0) { const bf16x8 a0 = *(const LAS bf16x8*)(lds + kbase + d0 * 32); pa = __builtin_amdgcn_mfma_f32_32x32x16_bf16(a0, qr[d0], d0 == 0 ? zero : pa, 0, 0, 0); }
#pragma unroll
      for (int d0 = 0; d0 < 6; ++d0) { const bf16x8 a0 = *(const LAS bf16x8*)(lds + kbase + 32 * KROW + d0 * 32); pb = __builtin_amdgcn_mfma_f32_32x32x16_bf16(a0, qr[d0], d0 == 0 ? zero : pb, 0, 0, 0); }
      ATT_MASK(pa, 0);
      float mx = fmaxf(pa[0], pa[1]);
#pragma unroll
      for (int r = 2; r < 16; r += 2) mx = max3f(mx, pa[r], pa[r + 1]);
      mx = fmaxf(mx, __shfl_xor(mx, 32));
      ATT_DECIDE(mx, pa, pb); }
#define ATT_HSTEP(C, B, N, hs, KN, KN2, VB, PRE) do { \
        if (32 * (hs) <= wq_hi) { \
            if (((hs) & 1) == 0) { kf0 = *(const LAS bf16x8*)(KN); kf1 = *(const LAS bf16x8*)((KN) + 32); } \
            const bool needb_ = 32 * ((hs) + 1) <= wq_hi; \
            if (needb_) ATT_MASK(B, (hs) + 1); \
            const float mx_ = attn_half<PRE>(C, B, N, o0, o1, lsum, (KN), (KN2), (VB), qr, negm, kf0, kf1); \
            if (needb_) ATT_DECIDE(mx_, B, N); \
        } } while (0)
#define ATT_TILE(t, CUR, NXT, NN, A0, A1, A2) do { \
        if ((t) + 2 < NT) ATT_LOAD((t) + 2); \
        ATT_HSTEP(A0, A1, A2, 2 * (t), lds + (NXT) * ABUF + kbase, lds + (NXT) * ABUF + kbase + 32 * KROW, lds + (CUR) * ABUF + vbase, true); \
        ATT_HSTEP(A1, A2, A0, 2 * (t) + 1, lds + (NXT) * ABUF + kbase + 32 * KROW, lds, lds + (CUR) * ABUF + vbase + 64, false); \
        if ((t) + 2 < NT) ATT_STORE((NN) * ABUF); \
        __syncthreads(); } while (0)
    bf16x8 kf0 = {}, kf1 = {};
    for (int t = 0; t < NT; t += 3) {
        ATT_TILE(t, 0, 1, 2, pa, pb, pc);
        if (t + 1 >= NT) break;
        ATT_TILE(t + 1, 1, 2, 0, pc, pa, pb);
        if (t + 2 >= NT) break;
        ATT_TILE(t + 2, 2, 0, 1, pb, pc, pa);
    }
#undef ATT_TILE
#undef ATT_HSTEP
#undef ATT_MASK
#undef ATT_DECIDE
#undef ATT_LOAD
#undef ATT_STORE
    lsum += __shfl_xor(lsum, 32);
    const float inv = 1.0f / lsum;
    bf16_t* op = O + tok * DM + h * 64;
#pragma unroll
    for (int g = 0; g < 4; ++g) {
        u32x2 a, d; a.x = pk2(o0[4 * g] * inv, o0[4 * g + 1] * inv); a.y = pk2(o0[4 * g + 2] * inv, o0[4 * g + 3] * inv);
        d.x = pk2(o1[4 * g] * inv, o1[4 * g + 1] * inv); d.y = pk2(o1[4 * g + 2] * inv, o1[4 * g + 3] * inv);
        *(u32x2*)(op + 8 * g + 4 * hi) = a; *(u32x2*)(op + 32 + 8 * g + 4 * hi) = d;
    }
}
__device__ __forceinline__ void phase_attn(const Params& P, LAS unsigned char* lds, int vcu, int G, int tid, int wave, int lane) {
    unsigned char* ws = P.ws;
    const bf16_t* Q = (const bf16_t*)(ws + WS_Q); const bf16_t* K = (const bf16_t*)(ws + WS_K); const bf16_t* Vt = (const bf16_t*)(ws + WS_VT); bf16_t* O = (bf16_t*)(ws + WS_CAT);
    for (int v = vcu; v < 256; v += G) {
        const int bh = v >> 2, j = v & 3;
        for (int i = 0; i < 4; ++i) { const int qb = (i == 0) ? 15 - 2 * j : (i == 1) ? 2 * j : (i == 2) ? 14 - 2 * j : 2 * j + 1;
            attn_unit(bh >> 3, bh & 7, qb, Q, K, Vt, (const float*)(ws + WS_CS), O, lds, tid, wave, lane); }
    }
}

#define XB_TMO      128
#define XB_XCNT(j)  (256  + 64 * (j))
#define XB_XSUB(j)  (1280 + 64 * (j))
#define XB_XGEN(j)  (2304 + 64 * (j))
#define XB_TOP      3328
#define XB_TOPGEN   3392
#define XCD_BAR_WORDS 3456
#define XB_SPIN_CAP (1u << 18)

__device__ __forceinline__ unsigned xb_ld(unsigned* p)              { return __hip_atomic_load(p, __ATOMIC_RELAXED, __HIP_MEMORY_SCOPE_AGENT); }
__device__ __forceinline__ unsigned xb_add(unsigned* p, unsigned v) { return __hip_atomic_fetch_add(p, v, __ATOMIC_RELAXED, __HIP_MEMORY_SCOPE_AGENT); }
__device__ __forceinline__ unsigned xb_xcc_id() { return (unsigned)__builtin_amdgcn_s_getreg((3 << 11) | 20) & 0xFu; }
#define XB_SPIN(cond, bar) do { unsigned _sp = 0; while (cond) { __builtin_amdgcn_s_sleep(1); \
    if ((++_sp & 255u) == 0u) { if (xb_ld(&(bar)[XB_TMO])) break; if (_sp > XB_SPIN_CAP) { atomicAdd(&(bar)[XB_TMO], 1u); break; } } } } while (0)

struct XcdBarrier {
    unsigned* bar; unsigned x;
    volatile LAS unsigned* st;
};

__device__ __forceinline__ XcdBarrier xcd_barrier_post(unsigned* bar, volatile LAS unsigned* st) {
    XcdBarrier b; b.bar = bar; b.x = xb_xcc_id(); b.st = st;
    if (threadIdx.x == 0) (void)xb_add(&bar[XB_XCNT(b.x)], 1u);
    return b;
}
__device__ __forceinline__ void xcd_barrier_complete(unsigned* bar, unsigned x, unsigned& nloc, unsigned& nx) {
    const unsigned G = gridDim.x * gridDim.y * gridDim.z;
    unsigned sum, cnt, mine, sp = 0u;
    for (;;) {
        sum = 0u; cnt = 0u; mine = 0u;
#pragma unroll
        for (unsigned j = 0; j < 16; ++j) { const unsigned c = xb_ld(&bar[XB_XCNT(j)]); sum += c; cnt += (c > 0u) ? 1u : 0u; mine = (j == x) ? c : mine; }
        if (sum == G) break;
        __builtin_amdgcn_s_sleep(1);
        if ((++sp & 255u) == 0u) { if (xb_ld(&bar[XB_TMO])) break; if (sp > XB_SPIN_CAP) { atomicAdd(&bar[XB_TMO], 1u); break; } }
    }
    nloc = mine > 0u ? mine : 1u; nx = cnt > 0u ? cnt : 1u;
}

__device__ __forceinline__ void xcd_barrier(const XcdBarrier& b) {
    asm volatile("s_waitcnt vmcnt(0)" ::: "memory");
    __syncthreads();
    if (threadIdx.x == 0) {
        unsigned* bar = b.bar;
        __builtin_amdgcn_s_waitcnt(0);
        unsigned nloc = b.st[0], nx = b.st[1];
        if (nloc == 0u) { xcd_barrier_complete(bar, b.x, nloc, nx); b.st[0] = nloc; b.st[1] = nx; }
        const unsigned old = xb_add(&bar[XB_XSUB(b.x)], 1u);
        const unsigned gen = old / nloc;
        if (old + 1u == (gen + 1u) * nloc) {
            __builtin_amdgcn_fence(__ATOMIC_RELEASE, "agent");
            asm volatile("s_waitcnt vmcnt(0)" ::: "memory");
            const unsigned og = xb_add(&bar[XB_TOP], 1u);
            const unsigned tg = og / nx;
            if (og + 1u == (tg + 1u) * nx) xb_add(&bar[XB_TOPGEN], 1u);
            else XB_SPIN(xb_ld(&bar[XB_TOPGEN]) == tg, bar);
            __builtin_amdgcn_fence(__ATOMIC_ACQUIRE, "agent");
            xb_add(&bar[XB_XGEN(b.x)], 1u);
            asm volatile("s_waitcnt vmcnt(0)" ::: "memory");
        } else {
            XB_SPIN(xb_ld(&bar[XB_XGEN(b.x)]) == gen, bar);
            __builtin_amdgcn_fence(__ATOMIC_ACQUIRE, "agent");
            asm volatile("s_waitcnt vmcnt(0)" ::: "memory");
        }
    }
    __syncthreads();
}

__global__ void __launch_bounds__(512) hymba_fwd(Params P) {
    extern __shared__ __attribute__((aligned(16))) unsigned char lds_raw[];
    LAS unsigned char* lds = (LAS unsigned char*)lds_raw;
    const int tid = threadIdx.x, lane = tid & 63, wave = __builtin_amdgcn_readfirstlane(tid >> 6);
    const int G = gridDim.x, bx = blockIdx.x;
    const int vcu = (G % 8 == 0) ? (bx % 8) * (G / 8) + bx / 8 : bx;
    unsigned char* ws = P.ws;
    bf16_t* XB = (bf16_t*)(ws + WS_XB);
    const int lo = P.ph_lo, hi = P.ph_hi;
    volatile LAS unsigned* bst = (volatile LAS unsigned*)(lds + 131072 + 512);
    if (tid < 2) bst[tid] = 0u;
    __syncthreads();
    XcdBarrier bar; bar.bar = (unsigned*)(ws + WS_BAR); bar.x = 0; bar.st = bst;
#ifndef PHASE_MASK
#define PHASE_MASK 0x1FF
#endif
#ifndef REP_MASK
#define REP_MASK 0x000
#endif
#define IN(k) ((((PHASE_MASK) >> (k)) & 1) && lo <= (k) && (k) < hi)
#define SEAM(k) do { if (IN(k) && IN((k) + 1)) { if ((k) == 0) cg::this_grid().sync(); else xcd_barrier(bar); } } while (0)
    if (IN(0)) { phase_prologue(P, lds, vcu, G, wave, lane);
        { u32x4* zc = (u32x4*)(ws + WS_CTL); const u32x4 z = {0u, 0u, 0u, 0u}; const int gtz = (vcu * 8 + wave) * 64 + lane;
          for (int i = gtz; i < (int)((CTL_BYTES + BAR_BYTES + FLAG_BYTES + ROWSS_BYTES) / 16); i += G * 512) zc[i] = z; }
        __syncthreads(); } SEAM(0);
    if (hi - lo > 1) bar = xcd_barrier_post((unsigned*)(ws + WS_BAR), bst);
    if (IN(1)) { { EpiProj E{(bf16_t*)(ws + WS_PROJ), (bf16_t*)(ws + WS_GLU)};
          run_gemm(lds, XB, (const bf16_t*)(ws + WS_WIN), TT, NPROJ_P, DM, G, bx, E); }
        { const bool hiw = bx >= G / 2; const size_t ro = hiw ? 0 : 24576;
          EpiPe E{(bf16_t*)(ws + WS_PE) + ro * DM, (float*)(ws + WS_ROWSS) + ro};
          run_gemm(lds, (const bf16_t*)(ws + WS_PBF) + ro * PLE, (const bf16_t*)(ws + WS_WPP), hiw ? 24576 : 8192, DM, PLE, G / 2, hiw ? bx - G / 2 : bx, E); }
    } SEAM(1);
    if (IN(2)) { phase_r1(P, lds, vcu, G, tid, wave, lane); } SEAM(2);
    if (IN(3)) {
#pragma nounroll
        for (int gi = 0; gi < 3; ++gi) {
            const bf16_t* A = (const bf16_t*)(ws + (gi == 0 ? WS_QAN : gi == 1 ? WS_KVAN : WS_WV));
            const bf16_t* Bt = (const bf16_t*)(ws + (gi == 0 ? WS_WQ : gi == 1 ? WS_WK : WS_KVAN));
            const int M = gi == 2 ? 512 : TT, N = gi == 0 ? NQ : gi == 1 ? 512 : TT, K = gi == 0 ? QL : KVL;
            EpiStore E{(bf16_t*)(ws + (gi == 0 ? WS_Q : gi == 1 ? WS_K : WS_VT)), gi == 2 ? (long)SEQ : (long)NQ, gi == 0 ? 30 : gi == 1 ? 6 : 12, gi == 1 ? 96L : gi == 2 ? 512L * SEQ : 0L};
            const bool upk = gi == 1; const bool hiw = bx >= G / 2;
            run_gemm(lds, A, Bt, (upk && !hiw) ? 0 : M, N, K, upk ? G / 2 : G, (upk && hiw) ? bx - G / 2 : bx, E);
        }
    } SEAM(3);
    if (IN(4)) { phase_attn(P, lds, vcu, G, tid, wave, lane); } SEAM(4);
    if (IN(5)) {
        PanelSumsq s1{(float*)(ws + WS_SLOT), (unsigned*)(ws + WS_CTL), 0, EPS}, s2{(float*)(ws + WS_SLOT + SLOT_BANK), (unsigned*)(ws + WS_CTL) + 128 * 64, 0, EPS};
        EpiWo E{P.x, (bf16_t*)(ws + WS_H1B), XB, P.g_mix_post, P.g_ffn_pre, s1, s2, lds + 131072 + 5120};
        run_gemm(lds, (const bf16_t*)(ws + WS_CAT), (const bf16_t*)(ws + WS_WO), TT, DM, DM, G, bx, E);
    } SEAM(5);
    if (IN(6)) { EpiGU E{(bf16_t*)(ws + WS_ACT), P.dw_w, P.dw_b, (float*)(ws + WS_HALO), (unsigned*)(ws + WS_FLAG), (PG8_LAS float*)(lds + 131072 + 1024)};
        run_gemm(lds, XB, (const bf16_t*)(ws + WS_WG), TT, 2 * DFF, DM, G, bx, E); } SEAM(6);
    if (IN(7)) {
        PanelSumsq s3{(float*)(ws + WS_SLOT + 2 * SLOT_BANK), (unsigned*)(ws + WS_CTL) + 2 * 128 * 64, 0, EPS};
        EpiDown E{(const bf16_t*)(ws + WS_H1B), XB, P.g_ffn_post, s3, lds + 131072 + 5120};
        run_gemm(lds, (const bf16_t*)(ws + WS_ACT), (const bf16_t*)(ws + WS_WD), TT, DM, DFF, G, bx, E);
    } SEAM(7);
    if (IN(8)) { EpiOut E{P.out, XB, (const bf16_t*)(ws + WS_PE), (const float*)(ws + WS_ROWSS), P.g_ple};
        run_gemm(lds, XB, (const bf16_t*)(ws + WS_WPG), TT, DM, DM, G, bx, E); }
#undef IN
#undef SEAM
}

#ifndef N_LAUNCHES
#define N_LAUNCHES 1
#endif
extern "C" void kernel_launch(void* const* d_in, const int* in_sizes, int n_in, void* d_out, int out_size, void* d_ws, size_t ws_size, hipStream_t stream) {
    static int grid = 0;
    if (grid == 0) {
        if (n_in != 25 || in_sizes[0] != TT * DM || out_size != TT * DM || ws_size < WS_END) {
            fprintf(stderr, "kernel_launch: unexpected problem: n_in %d in0 %d out %d ws %zu (need %zu)\n", n_in, n_in > 0 ? in_sizes[0] : -1, out_size, ws_size, (size_t)WS_END); grid = -1; return; }
        int dev = 0, cus = 0, per_cu = 0;
        hipGetDevice(&dev); hipDeviceGetAttribute(&cus, hipDeviceAttributeMultiprocessorCount, dev);
        if (hipFuncSetAttribute((const void*)hymba_fwd, hipFuncAttributeMaxDynamicSharedMemorySize, LDS_BYTES) != hipSuccess) { fprintf(stderr, "kernel_launch: hipFuncSetAttribute failed\n"); grid = -1; return; }
        if (hipOccupancyMaxActiveBlocksPerMultiprocessor(&per_cu, (const void*)hymba_fwd, 512, LDS_BYTES) != hipSuccess || per_cu < 1) { fprintf(stderr, "kernel_launch: occupancy query says %d\n", per_cu); per_cu = 1; }
        (void)hipGetLastError();
        grid = 256;
        if (cus != 256) fprintf(stderr, "kernel_launch: device has %d CUs, kernel is built for 256\n", cus);
    }
    if (grid < 0) return;
    Params a{};
    a.x = (const float*)d_in[0]; a.p = (const float*)d_in[1]; a.pos = (const int*)d_in[2];
    a.g_mix_pre = (const float*)d_in[3]; a.w_in = (const float*)d_in[4]; a.g_q_a = (const float*)d_in[5]; a.w_q_b = (const float*)d_in[6];
    a.g_kv_a = (const float*)d_in[7]; a.w_kv_b = (const float*)d_in[8]; a.conv_w = (const float*)d_in[9]; a.conv_b = (const float*)d_in[10];
    a.conv_ln_g = (const float*)d_in[11]; a.conv_ln_b = (const float*)d_in[12]; a.w_o = (const float*)d_in[13]; a.g_mix_post = (const float*)d_in[14];
    a.g_ffn_pre = (const float*)d_in[15]; a.w_gate = (const float*)d_in[16]; a.w_up = (const float*)d_in[17]; a.dw_w = (const float*)d_in[18];
    a.dw_b = (const float*)d_in[19]; a.w_down = (const float*)d_in[20]; a.g_ffn_post = (const float*)d_in[21]; a.w_ple_proj = (const float*)d_in[22];
    a.g_ple = (const float*)d_in[23]; a.w_ple_gate = (const float*)d_in[24];
    a.out = (float*)d_out; a.ws = (unsigned char*)d_ws;
#if N_LAUNCHES == 1
    a.ph_lo = 0; a.ph_hi = NPHASE;
    void* args[] = {&a};
    hipError_t e = hipLaunchCooperativeKernel((const void*)hymba_fwd, dim3(grid), dim3(512), args, LDS_BYTES, stream);
    if (e != hipSuccess) fprintf(stderr, "kernel_launch: cooperative launch failed: %s (grid %d)\n", hipGetErrorString(e), grid);
#else
    for (int ph = 0; ph < NPHASE; ++ph) for (int rep = 0; rep <= (((REP_MASK) >> ph) & 1); ++rep) {
        a.ph_lo = ph; a.ph_hi = ph + 1;
        hipLaunchKernelGGL(hymba_fwd, dim3(grid), dim3(512), LDS_BYTES, stream, a);
    }
#endif
}
```

```cpp
#include <hip/hip_runtime.h>
#include <hip/hip_cooperative_groups.h>
#include <cstdio>
#include <cstdint>
#include <cmath>
namespace cg = cooperative_groups;
namespace pg8 {
#define PG8_LAS __attribute__((address_space(3)))
typedef unsigned short bf16_t;
typedef short bf16x8 __attribute__((ext_vector_type(8)));
typedef float f32x4 __attribute__((ext_vector_type(4)));
typedef unsigned u32x4 __attribute__((ext_vector_type(4)));
constexpr int BM = 256, BK = 64, HALF = 128, HTB = HALF * BK * 2  , STAGE_BYTES = 8 * HTB, NXCD = 8, WGM = 8;

__host__ __device__ __forceinline__ int lds_byte(int r, int c) { const int st = (r >> 4) * 2 + (c >> 5), rr = r & 15, cc = c & 31, ob = rr * 64 + cc * 2; return st * 1024 + (ob ^ (((ob >> 9) & 1) << 5)); }
__host__ __device__ __forceinline__ void stage_rc(int b, int& R, int& C) { const int st = b / 1024, sb = b % 1024, swz = sb ^ (((sb >> 9) & 1) << 5); R = (st >> 1) * 16 + swz / 64; C = (st & 1) * 32 + (swz % 64) / 2; }
__host__ __device__ __forceinline__ int perm32(int rho) { const int n = rho >> 4, i = rho & 15; return 8 * (i >> 2) + 4 * n + (i & 3); }

struct Unit { int pm, pn; };
struct Gemm { const bf16_t* A; const bf16_t* Bt; int M, N, K; };

struct StaticOrder {
    int nM, nN, nwg, G, c;
    __host__ __device__ void init(int M, int N, int G_, int c_) { nM = M / BM; nN = N / BM; nwg = nM * nN; G = G_; c = c_; }
    __host__ __device__ bool next(int i, Unit& u) const {
        const int L = i * G + c; if (L >= nwg) return false;
        int wgid = L; { const int q = nwg / NXCD, r = nwg % NXCD, xcd = wgid % NXCD, off = wgid / NXCD; wgid = (xcd < r ? xcd * (q + 1) : r * (q + 1) + (xcd - r) * q) + off; }
        const int nig = WGM * nN, gid = wgid / nig, fm = gid * WGM, gsz = (nM - fm) < WGM ? (nM - fm) : WGM;
        u.pm = fm + ((wgid % nig) % gsz); u.pn = (wgid % nig) / gsz; return true;
    }
    __device__ __forceinline__ void a_ready(const Unit&) const {}
    __device__ __forceinline__ void done(const Unit&) const {}
};
__device__ __forceinline__ unsigned cvt_pk_bf16(float lo, float hi) { unsigned r; asm volatile("v_cvt_pk_bf16_f32 %0, %1, %2" : "=v"(r) : "v"(lo), "v"(hi)); return r; }
template <class Epi, class Sched, bool ALIGN_EPI = false, bool SP2 = false>
__device__ __forceinline__ void gemm_phase(PG8_LAS unsigned char* lds, const Gemm g, const Sched& S, const Epi& E) {
    const int tid = threadIdx.x, wid = __builtin_amdgcn_readfirstlane(tid >> 6), lane = tid & 63, wr = wid >> 2, wc = wid & 3, fr = lane & 15, fq = lane >> 4;
    const int K = g.K, nt = K / BK;
    unsigned voffA[2], voffB[2];
#pragma unroll
    for (int i = 0; i < 2; ++i) { int R, C; stage_rc(tid * 16 + i * 8192, R, C); const int Rb = Epi::PERM ? ((R & ~31) + perm32(R & 31)) : R;
        voffA[i] = (unsigned)(R * K + C) * 2u; voffB[i] = (unsigned)(Rb * K + C) * 2u; }
    const size_t kstep = (size_t)(BK * 2);
    const size_t hstep = (size_t)HALF * K * 2;
    const size_t tstep = 2 * hstep;
    const unsigned ldsw = (unsigned)wid * 1024u;
    const int aoff = lds_byte(wr * 64 + fr, fq * 8), boff = lds_byte(wc * 32 + fr, fq * 8);
#define PG8_SA(b, h) (((b) * 2 + (h)) * HTB)
#define PG8_SB(b, h) ((4 + (b) * 2 + (h)) * HTB)
#define PG8_STAGE(bufoff, gbase, voff) do { _Pragma("unroll") for (int _i = 0; _i < 2; ++_i) \
        __builtin_amdgcn_global_load_lds((const unsigned*)((const char*)(gbase) + (voff)[_i]), (PG8_LAS unsigned*)(lds + (bufoff) + ldsw + _i * 8192), 16, 0, 0); } while (0)
#define PG8_LDA(dst, b, h) do { _Pragma("unroll") for (int m = 0; m < 4; ++m) _Pragma("unroll") for (int k = 0; k < 2; ++k) dst[m][k] = *(const PG8_LAS bf16x8*)(lds + PG8_SA(b, h) + aoff + m * 2048 + k * 1024); } while (0)
#define PG8_LDB(dst, b, h) do { _Pragma("unroll") for (int n = 0; n < 2; ++n) _Pragma("unroll") for (int k = 0; k < 2; ++k) dst[n][k] = *(const PG8_LAS bf16x8*)(lds + PG8_SB(b, h) + boff + n * 2048 + k * 1024); } while (0)
#define PG8_MMA(ai, bj, At, Bt) do { __builtin_amdgcn_s_setprio(1); _Pragma("unroll") for (int m = 0; m < 4; ++m) _Pragma("unroll") for (int n = 0; n < 2; ++n) _Pragma("unroll") for (int k = 0; k < 2; ++k) \
        acc[ai][bj][m][n] = __builtin_amdgcn_mfma_f32_16x16x32_bf16(Bt[n][k], At[m][k], acc[ai][bj][m][n], 0, 0, 0); __builtin_amdgcn_s_setprio(0); } while (0)
#define PG8_WAIT_V(n) asm volatile("s_waitcnt vmcnt(" #n ")" ::: "memory")
#define PG8_WAIT_L(n) asm volatile("s_waitcnt lgkmcnt(" #n ")" ::: "memory")
#define PG8_BAR __builtin_amdgcn_s_barrier()
#define PG8_SCHED __builtin_amdgcn_sched_barrier(0)
    Unit cur, nxt; int ui = 0;
    if (!S.next(0, cur)) return;
    f32x4 acc[2][2][4][2];
#pragma unroll
    for (int a = 0; a < 2; ++a)
#pragma unroll
        for (int b = 0; b < 2; ++b)
#pragma unroll
            for (int m = 0; m < 4; ++m)
#pragma unroll
                for (int n = 0; n < 2; ++n) acc[a][b][m][n] = (f32x4){0.f, 0.f, 0.f, 0.f};
    bf16x8 At[4][2], B0[2][2], B1[2][2];
    const char* cA = (const char*)g.A + (size_t)cur.pm * tstep; const char* cB = (const char*)g.Bt + (size_t)cur.pn * tstep;
    S.a_ready(cur);
    if constexpr (SP2) {
        PG8_STAGE(PG8_SB(0, 0), cB, voffB); PG8_STAGE(PG8_SB(0, 1), cB + hstep, voffB); PG8_STAGE(PG8_SA(0, 0), cA, voffA); PG8_STAGE(PG8_SA(0, 1), cA + hstep, voffA);
        if (wr == 1) PG8_BAR;
        PG8_WAIT_V(2); PG8_BAR;
        PG8_STAGE(PG8_SB(1, 0), cB + kstep, voffB); PG8_STAGE(PG8_SA(1, 0), cA + kstep, voffA); PG8_STAGE(PG8_SB(1, 1), cB + hstep + kstep, voffB);
        PG8_WAIT_V(6); PG8_BAR;
    } else {
        PG8_STAGE(PG8_SB(0, 0), cB, voffB); PG8_STAGE(PG8_SA(0, 0), cA, voffA); PG8_STAGE(PG8_SB(0, 1), cB + hstep, voffB); PG8_STAGE(PG8_SA(0, 1), cA + hstep, voffA);
        if (wr == 1) PG8_BAR;
        PG8_WAIT_V(4); PG8_BAR;
        PG8_STAGE(PG8_SB(1, 0), cB + kstep, voffB); PG8_STAGE(PG8_SA(1, 0), cA + kstep, voffA); PG8_STAGE(PG8_SB(1, 1), cB + hstep + kstep, voffB);
        PG8_WAIT_V(6); PG8_BAR;
    }
    for (;;) {
        const bool has_next = S.next(ui + 1, nxt);
        const char* nA = has_next ? (const char*)g.A + (size_t)nxt.pm * tstep : cA; const char* nB = has_next ? (const char*)g.Bt + (size_t)nxt.pn * tstep : cB;
        for (int t = 0; t < nt; t += 2) {
            const bool last = (t == nt - 2);
            const char* a1 = cA + (size_t)(t + 1) * kstep;
            const char* a2 = last ? nA : cA + (size_t)(t + 2) * kstep; const char* b2 = last ? nB : cB + (size_t)(t + 2) * kstep;
            const char* a3 = a2 + kstep; const char* b3 = b2 + kstep;
            if (last && has_next) S.a_ready(nxt);
            if constexpr (SP2) {
            PG8_LDB(B0, 0, 0); PG8_LDB(B1, 0, 1); PG8_SCHED; PG8_LDA(At, 0, 0); PG8_STAGE(PG8_SA(1, 1), a1 + hstep, voffA);
            PG8_WAIT_V(8); PG8_WAIT_L(0); PG8_BAR; PG8_MMA(0, 0, At, B0); PG8_MMA(0, 1, At, B1); PG8_BAR; PG8_SCHED;
            PG8_LDA(At, 0, 1); PG8_STAGE(PG8_SB(0, 0), b2, voffB); PG8_STAGE(PG8_SB(0, 1), b2 + hstep, voffB); PG8_STAGE(PG8_SA(0, 0), a2, voffA);
            PG8_WAIT_V(8); PG8_WAIT_L(0); PG8_BAR; PG8_MMA(1, 0, At, B0); PG8_MMA(1, 1, At, B1); PG8_BAR; PG8_SCHED;
            PG8_LDB(B0, 1, 0); PG8_LDB(B1, 1, 1); PG8_SCHED; PG8_LDA(At, 1, 0); PG8_STAGE(PG8_SA(0, 1), a2 + hstep, voffA);
            PG8_WAIT_V(8); PG8_WAIT_L(0); PG8_BAR; PG8_MMA(0, 0, At, B0); PG8_MMA(0, 1, At, B1); PG8_BAR; PG8_SCHED;
            PG8_LDA(At, 1, 1); PG8_STAGE(PG8_SB(1, 0), b3, voffB); PG8_STAGE(PG8_SB(1, 1), b3 + hstep, voffB); PG8_STAGE(PG8_SA(1, 0), a3, voffA);
            PG8_WAIT_V(8); PG8_WAIT_L(0); PG8_BAR; PG8_MMA(1, 0, At, B0); PG8_MMA(1, 1, At, B1); PG8_BAR; PG8_SCHED;
            } else {
            PG8_LDB(B0, 0, 0); PG8_SCHED; PG8_LDA(At, 0, 0); PG8_STAGE(PG8_SA(1, 1), a1 + hstep, voffA);
            PG8_WAIT_L(8); PG8_BAR; PG8_WAIT_L(0); PG8_MMA(0, 0, At, B0); PG8_BAR; PG8_SCHED;
            PG8_LDB(B1, 0, 1); PG8_STAGE(PG8_SB(0, 0), b2, voffB);
            PG8_BAR; PG8_WAIT_L(0); PG8_MMA(0, 1, At, B1); PG8_BAR;
            PG8_LDA(At, 0, 1); PG8_STAGE(PG8_SA(0, 0), a2, voffA);
            PG8_BAR; PG8_WAIT_L(0); PG8_MMA(1, 0, At, B0); PG8_BAR; PG8_SCHED;
            PG8_STAGE(PG8_SB(0, 1), b2 + hstep, voffB);
            PG8_WAIT_V(6); PG8_BAR; PG8_MMA(1, 1, At, B1); PG8_BAR;
            PG8_LDB(B0, 1, 0); PG8_SCHED; PG8_LDA(At, 1, 0); PG8_STAGE(PG8_SA(0, 1), a2 + hstep, voffA);
            PG8_WAIT_L(8); PG8_BAR; PG8_WAIT_L(0); PG8_MMA(0, 0, At, B0); PG8_BAR; PG8_SCHED;
            PG8_LDB(B1, 1, 1); PG8_STAGE(PG8_SB(1, 0), b3, voffB);
            PG8_BAR; PG8_WAIT_L(0); PG8_MMA(0, 1, At, B1); PG8_BAR;
            PG8_LDA(At, 1, 1); PG8_STAGE(PG8_SA(1, 0), a3, voffA);
            PG8_BAR; PG8_WAIT_L(0); PG8_MMA(1, 0, At, B0); PG8_BAR; PG8_SCHED;
            PG8_STAGE(PG8_SB(1, 1), b3 + hstep, voffB);
            PG8_WAIT_V(6); PG8_BAR; PG8_MMA(1, 1, At, B1); PG8_BAR;
            }
        }
        if constexpr (ALIGN_EPI) { if (wr == 0) PG8_BAR; }
        if constexpr (!Epi::AFTER_DRAIN) { E(acc, cur, wr, wc, fr, fq); S.done(cur); }
        if (!has_next) break;
#pragma unroll
        for (int a = 0; a < 2; ++a)
#pragma unroll
            for (int b = 0; b < 2; ++b)
#pragma unroll
                for (int m = 0; m < 4; ++m)
#pragma unroll
                    for (int n = 0; n < 2; ++n) acc[a][b][m][n] = (f32x4){0.f, 0.f, 0.f, 0.f};
        cur = nxt; cA = nA; cB = nB; ++ui;
        if constexpr (ALIGN_EPI) { if (wr == 1) PG8_BAR; }
    }
    PG8_WAIT_V(0);
    if constexpr (!ALIGN_EPI) { if (wr == 0) PG8_BAR; }
    PG8_BAR;
    if constexpr (Epi::AFTER_DRAIN) { E.fused(acc, cur, wr, wc, fr, fq, lds, wid, lane); S.done(cur); }
#undef PG8_SA
#undef PG8_SB
#undef PG8_STAGE
#undef PG8_LDA
#undef PG8_LDB
#undef PG8_MMA
#undef PG8_WAIT_V
#undef PG8_WAIT_L
#undef PG8_BAR
#undef PG8_SCHED
}
}

using pg8::bf16_t; using pg8::f32x4; using pg8::u32x4; using pg8::Unit;
typedef short bf16x8 __attribute__((ext_vector_type(8)));
typedef float f32x16 __attribute__((ext_vector_type(16)));
typedef unsigned u32x2 __attribute__((ext_vector_type(2)));
#define LAS __attribute__((address_space(3)))

constexpr int TT = 32768, SEQ = 4096, DM = 1024, NPROJ = 1696, NPROJ_P = 1792, PROJ_LD = 768, QL = 384, KVL = 256, NQ = 768, DFF = 2816, PLE = 256;
constexpr int NHEAD = 8, CONVC = 512, CONVW = 31;
constexpr float EPS = 1e-6f;
constexpr float QSCALE = 0.10206207261596575f * 1.4426950408889634f;
constexpr size_t MiB = 1u << 20;
constexpr size_t WS_WIN = 1 * MiB, WS_WQ = 5 * MiB, WS_WK = 6 * MiB, WS_WV = 6 * MiB + 512 * 1024, WS_WO = 7 * MiB, WS_WG = 9 * MiB, WS_WU = 15 * MiB,
                 WS_WD = 21 * MiB, WS_WPP = 27 * MiB, WS_WPG = 28 * MiB, WS_CS = 30 * MiB, WS_RSTD = 34 * MiB, WS_CTL = 35 * MiB, WS_SLOT = 36 * MiB;
constexpr size_t CTL_BYTES = 4 * 128 * 256, BAR_BYTES = 16384, WS_BAR = WS_CTL + 4 * 128 * 256, FLAG_BYTES = 16384, WS_FLAG = WS_BAR + 16384, ROWSS_BYTES = 131072, WS_ROWSS = WS_FLAG + 16384, SLOT_BANK = (size_t)128 * 256 * 4 * 4;
constexpr size_t WS_XB = 40 * MiB, WS_PBF = 104 * MiB, WS_PROJ = 120 * MiB, WS_QAN = 232 * MiB, WS_KVAN = 256 * MiB, WS_CAT = 272 * MiB,
                 WS_GLU = 168 * MiB, WS_K = 336 * MiB, WS_Q = 120 * MiB, WS_VT = 168 * MiB, WS_ACT = 120 * MiB, WS_HALO = 296 * MiB, WS_H1B = 336 * MiB, WS_PE = 400 * MiB, WS_END = 472 * MiB;
constexpr int LDS_BYTES = 147456;
constexpr int NPHASE = 9;

struct Params {
    const float* x; const float* p; const int* pos;
    const float *g_mix_pre, *w_in, *g_q_a, *w_q_b, *g_kv_a, *w_kv_b, *conv_w, *conv_b, *conv_ln_g, *conv_ln_b, *w_o, *g_mix_post, *g_ffn_pre,
                *w_gate, *w_up, *dw_w, *dw_b, *w_down, *g_ffn_post, *w_ple_proj, *g_ple, *w_ple_gate;
    float* out; unsigned char* ws; int ph_lo, ph_hi;
};

__device__ __forceinline__ float bf_lo(unsigned w) { return __uint_as_float(w << 16); }
__device__ __forceinline__ float bf_hi(unsigned w) { return __uint_as_float(w & 0xffff0000u); }
__device__ __forceinline__ float bf1(bf16_t h) { return __uint_as_float((unsigned)h << 16); }
__device__ __forceinline__ unsigned pk2(float lo, float hi) { return pg8::cvt_pk_bf16(lo, hi); }
__device__ __forceinline__ float wave_sum(float v) {
#define WS_DPP(ctrl, rmask) v += __int_as_float(__builtin_amdgcn_update_dpp(0, __float_as_int(v), (ctrl), (rmask), 0xf, true))
    WS_DPP(0x111, 0xf); WS_DPP(0x112, 0xf); WS_DPP(0x114, 0xf); WS_DPP(0x118, 0xf);
    WS_DPP(0x142, 0xa);
    WS_DPP(0x143, 0xc);
#undef WS_DPP
    return __int_as_float(__builtin_amdgcn_readlane(__float_as_int(v), 63));
}
__device__ __forceinline__ float fast_sigmoid(float x) { return __builtin_amdgcn_rcpf(1.0f + __builtin_amdgcn_exp2f(-1.4426950408889634f * x)); }
__device__ __forceinline__ float gelu_tanh(float g) {
    const float u = 0.7978845608028654f * (g + 0.044715f * g * g * g);
    return g * __builtin_amdgcn_rcpf(1.0f + __builtin_amdgcn_exp2f(-2.0f * 1.4426950408889634f * u));
}
typedef float f32x2 __attribute__((ext_vector_type(2)));
__device__ __forceinline__ f32x2 fast_sigmoid2(f32x2 x) { const f32x2 z = x * (-1.4426950408889634f); f32x2 e; e.x = __builtin_amdgcn_exp2f(z.x); e.y = __builtin_amdgcn_exp2f(z.y);
    const f32x2 d = e + 1.0f; f32x2 r; r.x = __builtin_amdgcn_rcpf(d.x); r.y = __builtin_amdgcn_rcpf(d.y); return r; }
__device__ __forceinline__ f32x2 gelu_tanh2(f32x2 g) { const f32x2 t = (g * g) * 0.044715f + 1.0f; const f32x2 z = (g * t) * (-2.0f * 0.7978845608028654f * 1.4426950408889634f);
    f32x2 e; e.x = __builtin_amdgcn_exp2f(z.x); e.y = __builtin_amdgcn_exp2f(z.y); const f32x2 d = e + 1.0f; f32x2 r; r.x = __builtin_amdgcn_rcpf(d.x); r.y = __builtin_amdgcn_rcpf(d.y); return g * r; }
__device__ __forceinline__ void unpack8(const u32x4 w, float (&f)[8]) {
    f[0] = bf_lo(w.x); f[1] = bf_hi(w.x); f[2] = bf_lo(w.y); f[3] = bf_hi(w.y); f[4] = bf_lo(w.z); f[5] = bf_hi(w.z); f[6] = bf_lo(w.w); f[7] = bf_hi(w.w);
}
__device__ __forceinline__ u32x4 pack8(const float (&f)[8]) { u32x4 w; w.x = pk2(f[0], f[1]); w.y = pk2(f[2], f[3]); w.z = pk2(f[4], f[5]); w.w = pk2(f[6], f[7]); return w; }

struct EpiStore {
    static constexpr bool PERM = true, AFTER_DRAIN = false;
    bf16_t* O; long ldc; int lg; long S;
    __device__ __forceinline__ void operator()(const f32x4 (&acc)[2][2][4][2], const Unit& u, int wr, int wc, int fr, int fq) const {
        const int row0 = u.pm * 256 + wr * 64 + fr, c0 = u.pn * 256 + wc * 32 + 8 * fq;
#pragma unroll
        for (int bj = 0; bj < 2; ++bj) { const int c = c0 + bj * 128; const long dcol = (long)(c >> lg) * S + (c & ((1 << lg) - 1));
#pragma unroll
            for (int ai = 0; ai < 2; ++ai)
#pragma unroll
                for (int m = 0; m < 4; ++m) { const f32x4 v0 = acc[ai][bj][m][0], v1 = acc[ai][bj][m][1]; u32x4 w;
                    w.x = pk2(v0[0], v0[1]); w.y = pk2(v0[2], v0[3]); w.z = pk2(v1[0], v1[1]); w.w = pk2(v1[2], v1[3]);
                    *(u32x4*)(O + (long)(row0 + ai * 128 + m * 16) * ldc + dcol) = w; } }
    }
};
struct EpiProj {
    static constexpr bool PERM = true, AFTER_DRAIN = false;
    bf16_t* proj; bf16_t* glu;
    __device__ __forceinline__ void operator()(const f32x4 (&acc)[2][2][4][2], const Unit& u, int wr, int wc, int fr, int fq) const {
        const int row0 = u.pm * 256 + wr * 64 + fr, lc = wc * 32 + 8 * fq;
        if (u.pn < 3) {
#pragma unroll
            for (int bj = 0; bj < 2; ++bj)
#pragma unroll
                for (int ai = 0; ai < 2; ++ai)
#pragma unroll
                    for (int m = 0; m < 4; ++m) { const f32x4 v0 = acc[ai][bj][m][0], v1 = acc[ai][bj][m][1]; u32x4 w;
                        w.x = pk2(v0[0], v0[1]); w.y = pk2(v0[2], v0[3]); w.z = pk2(v1[0], v1[1]); w.w = pk2(v1[2], v1[3]);
                        *(u32x4*)(proj + (long)(row0 + ai * 128 + m * 16) * PROJ_LD + u.pn * 256 + bj * 128 + lc) = w; }
        } else {
#pragma unroll
            for (int ai = 0; ai < 2; ++ai)
#pragma unroll
                for (int m = 0; m < 4; ++m) { float o[8];
#pragma unroll
                    for (int e = 0; e < 8; e += 2) { const f32x2 a = {acc[ai][0][m][e >> 2][e & 3], acc[ai][0][m][(e + 1) >> 2][(e + 1) & 3]}, gt = {acc[ai][1][m][e >> 2][e & 3], acc[ai][1][m][(e + 1) >> 2][(e + 1) & 3]};
                        const f32x2 r = a * fast_sigmoid2(gt); o[e] = r.x; o[e + 1] = r.y; }
                    *(u32x4*)(glu + (long)(row0 + ai * 128 + m * 16) * CONVC + (u.pn - 3) * 128 + lc) = pack8(o); }
        }
    }
};
__device__ __forceinline__ float dpp_shr1(float old, float src) { return __int_as_float(__builtin_amdgcn_update_dpp(__float_as_int(old), __float_as_int(src), 0x111, 0xf, 0xf, false)); }
__device__ __forceinline__ float dpp_shr2(float old, float src) { return __int_as_float(__builtin_amdgcn_update_dpp(__float_as_int(old), __float_as_int(src), 0x112, 0xf, 0xf, false)); }
__device__ __forceinline__ float dpp_ror1(float src) { return __int_as_float(__builtin_amdgcn_update_dpp(0, __float_as_int(src), 0x121, 0xf, 0xf, false)); }
__device__ __forceinline__ float dpp_ror2(float src) { return __int_as_float(__builtin_amdgcn_update_dpp(0, __float_as_int(src), 0x122, 0xf, 0xf, false)); }
struct EpiGU {
    static constexpr bool PERM = true, AFTER_DRAIN = false;
    bf16_t* act; const float* dw; const float* db; float* halo; unsigned* flag; PG8_LAS float* E;
    template <int AI, int M>
    __device__ __forceinline__ void rows16(const f32x4 (&acc)[2][2][4][2], const float (&P1)[8], const float (&P2)[8], const float (&w0)[8], const float (&w1)[8], const float (&w2)[8], const float (&bb)[8],
                                           long row, int c, int fr) const {
        float o[8];
#pragma unroll
        for (int e = 0; e < 8; e += 2) { f32x2 g, g1, g2;
#pragma unroll
            for (int k = 0; k < 2; ++k) { const int ee = e + k; const float gv = acc[AI][0][M][ee >> 2][ee & 3];
                float s1, s2;
                if (M > 0) { const float pv = acc[AI][0][M > 0 ? M - 1 : 0][ee >> 2][ee & 3]; s1 = dpp_ror1(pv); s2 = dpp_ror2(pv); }
                else { s1 = P1[ee]; s2 = fr == 0 ? P2[ee] : P1[ee]; }
                g[k] = gv; g1[k] = dpp_shr1(s1, gv); g2[k] = dpp_shr2(s2, gv); }
            const f32x2 w0v = {w0[e], w0[e + 1]}, w1v = {w1[e], w1[e + 1]}, w2v = {w2[e], w2[e + 1]}, bv = {bb[e], bb[e + 1]};
            const f32x2 upv = {acc[AI][1][M][e >> 2][e & 3], acc[AI][1][M][(e + 1) >> 2][(e + 1) & 3]};
            const f32x2 cv = bv + w0v * g2 + w1v * g1 + w2v * g;
            const f32x2 ov = gelu_tanh2(cv) * upv; o[e] = ov.x; o[e + 1] = ov.y; }
        *(u32x4*)(act + row * DFF + c) = pack8(o);
    }
    __device__ __forceinline__ void operator()(const f32x4 (&acc)[2][2][4][2], const Unit& u, int wr, int wc, int fr, int fq) const {
        const int lc = wc * 32 + 8 * fq;
        const int c = u.pn * 128 + lc;
        if (fr >= 14) {
#pragma unroll
            for (int ai = 0; ai < 2; ++ai)
#pragma unroll
                for (int n = 0; n < 2; ++n) *(PG8_LAS f32x4*)(E + ((ai * 2 + wr) * 2 + (fr - 14)) * 128 + lc + 4 * n) = acc[ai][0][3][n];
            if (wr == 1) { float* hp = halo + ((size_t)(u.pm * 22 + u.pn) * 2 + (fr - 14)) * 128 + lc;
#pragma unroll
                for (int n = 0; n < 2; ++n)
#pragma unroll
                    for (int e = 0; e < 4; ++e) __hip_atomic_store(hp + 4 * n + e, acc[1][0][3][n][e], __ATOMIC_RELAXED, __HIP_MEMORY_SCOPE_AGENT); }
        }
        if (wr == 1) { asm volatile("s_waitcnt vmcnt(0)" ::: "memory");
            if ((fr | fq) == 0) __hip_atomic_fetch_add(flag + u.pm * 22 + u.pn, 1u, __ATOMIC_RELAXED, __HIP_MEMORY_SCOPE_AGENT); }
        float w0[8], w1[8], w2[8], bb[8];
#pragma unroll
        for (int e = 0; e < 8; ++e) { w0[e] = dw[c + e]; w1[e] = dw[DFF + c + e]; w2[e] = dw[2 * DFF + c + e]; bb[e] = db[c + e]; }
        const long rb = (long)u.pm * 256 + wr * 64 + fr;
        const float Z[8] = {0.f, 0.f, 0.f, 0.f, 0.f, 0.f, 0.f, 0.f};
        rows16<1, 1>(acc, Z, Z, w0, w1, w2, bb, rb + 128 + 16, c, fr); rows16<1, 2>(acc, Z, Z, w0, w1, w2, bb, rb + 128 + 32, c, fr); rows16<1, 3>(acc, Z, Z, w0, w1, w2, bb, rb + 128 + 48, c, fr);
        rows16<0, 1>(acc, Z, Z, w0, w1, w2, bb, rb + 16, c, fr); rows16<0, 2>(acc, Z, Z, w0, w1, w2, bb, rb + 32, c, fr); rows16<0, 3>(acc, Z, Z, w0, w1, w2, bb, rb + 48, c, fr);
        asm volatile("s_waitcnt lgkmcnt(0)" ::: "memory"); __builtin_amdgcn_s_barrier(); asm volatile("" ::: "memory");
        { float P1[8], P2[8]; const int blk = 2 + wr;
#pragma unroll
          for (int n = 0; n < 2; ++n) { const f32x4 a = *(const PG8_LAS f32x4*)(E + ((blk - 1) * 2 + 1) * 128 + lc + 4 * n), d = *(const PG8_LAS f32x4*)(E + ((blk - 1) * 2 + 0) * 128 + lc + 4 * n);
#pragma unroll
              for (int e = 0; e < 4; ++e) { P1[4 * n + e] = a[e]; P2[4 * n + e] = d[e]; } }
          rows16<1, 0>(acc, P1, P2, w0, w1, w2, bb, rb + 128, c, fr); }
        { float P1[8], P2[8];
          const bool need_halo = (wr == 0) && ((u.pm & 15) != 0);
          if (wr == 1) {
#pragma unroll
              for (int n = 0; n < 2; ++n) { const f32x4 a = *(const PG8_LAS f32x4*)(E + 1 * 128 + lc + 4 * n), d = *(const PG8_LAS f32x4*)(E + lc + 4 * n);
#pragma unroll
                  for (int e = 0; e < 4; ++e) { P1[4 * n + e] = a[e]; P2[4 * n + e] = d[e]; } }
          } else if (need_halo) { unsigned* fp = flag + (u.pm - 1) * 22 + u.pn; unsigned spins = 0;
              while ((unsigned)__builtin_amdgcn_readfirstlane(__hip_atomic_load(fp, __ATOMIC_RELAXED, __HIP_MEMORY_SCOPE_AGENT)) < 4u) { if (++spins > (1u << 22)) break; __builtin_amdgcn_s_sleep(1); }
              const float* hp = halo + ((size_t)((u.pm - 1) * 22 + u.pn) * 2) * 128 + lc;
#pragma unroll
              for (int e = 0; e < 8; ++e) { P1[e] = __hip_atomic_load(hp + 128 + e, __ATOMIC_RELAXED, __HIP_MEMORY_SCOPE_AGENT); P2[e] = __hip_atomic_load(hp + e, __ATOMIC_RELAXED, __HIP_MEMORY_SCOPE_AGENT); }
          } else {
#pragma unroll
              for (int e = 0; e < 8; ++e) { P1[e] = 0.f; P2[e] = 0.f; }
          }
          rows16<0, 0>(acc, P1, P2, w0, w1, w2, bb, rb, c, fr); }
    }
};
struct PanelSumsq {
    float* xbuf; unsigned* cnt; int panel0; float eps;
    __device__ __forceinline__ void run(const f32x4 (&v)[2][2][4][2], const Unit& u, int wr, int wc, int fr, int fq, PG8_LAS unsigned char* lds, int wid, int lane) const {
        publish(v, u, wr, wc, fr, fq, lds, wid, lane); finish(u, lds, wid, lane);
    }
    __device__ __forceinline__ void publish(const f32x4 (&v)[2][2][4][2], const Unit& u, int wr, int wc, int fr, int fq, PG8_LAS unsigned char* lds, int wid, int lane) const {
        PG8_LAS float* Pp = (PG8_LAS float*)lds;
#pragma unroll
        for (int ai = 0; ai < 2; ++ai)
#pragma unroll
            for (int m = 0; m < 4; ++m) { float q = 0.f;
#pragma unroll
                for (int bj = 0; bj < 2; ++bj)
#pragma unroll
                    for (int n = 0; n < 2; ++n) { const f32x4 x = v[ai][bj][m][n]; q += (x[0] * x[0] + x[1] * x[1]) + (x[2] * x[2] + x[3] * x[3]); }
                q += __shfl_xor(q, 16); q += __shfl_xor(q, 32);
                if (fq == 0) Pp[(ai * 128 + wr * 64 + m * 16 + fr) * 4 + wc] = q; }
        asm volatile("s_waitcnt lgkmcnt(0)" ::: "memory"); __builtin_amdgcn_s_barrier(); asm volatile("" ::: "memory");
        const int row = wid * 32 + (lane & 31); const int panel = panel0 + u.pm;
        if (lane < 32) { const float tot = (Pp[row * 4 + 0] + Pp[row * 4 + 1]) + (Pp[row * 4 + 2] + Pp[row * 4 + 3]);
            __hip_atomic_store(xbuf + ((size_t)(panel * 256 + row) * 4 + u.pn), tot, __ATOMIC_RELAXED, __HIP_MEMORY_SCOPE_AGENT); }
        asm volatile("s_waitcnt vmcnt(0)" ::: "memory");
        if (lane == 0) __hip_atomic_fetch_add(cnt + 64 * panel, 1u, __ATOMIC_RELAXED, __HIP_MEMORY_SCOPE_AGENT);
    }
    __device__ __forceinline__ void finish(const Unit& u, PG8_LAS unsigned char* lds, int wid, int lane) const {
        PG8_LAS float* S = (PG8_LAS float*)(lds + 4096);
        const int row = wid * 32 + (lane & 31); const int panel = panel0 + u.pm;
        if (wid == 0) {
            unsigned spins = 0;
            for (;;) { if ((unsigned)__builtin_amdgcn_readfirstlane(__hip_atomic_load(cnt + 64 * panel, __ATOMIC_RELAXED, __HIP_MEMORY_SCOPE_AGENT)) >= 32u) break;
                if (++spins > (1u << 22)) break;
                __builtin_amdgcn_s_sleep(2); }
            __builtin_amdgcn_fence(__ATOMIC_ACQUIRE, "agent");
        }
        asm volatile("s_waitcnt vmcnt(0) lgkmcnt(0)" ::: "memory"); __builtin_amdgcn_s_barrier(); asm volatile("" ::: "memory");
        if (lane < 32) { const float* slot = xbuf + (size_t)(panel * 256 + row) * 4; float t = 0.f;
#pragma unroll
            for (int k = 0; k < 4; ++k) t += __hip_atomic_load(slot + k, __ATOMIC_RELAXED, __HIP_MEMORY_SCOPE_AGENT);
            S[row] = __builtin_amdgcn_rsqf(t * (1.0f / 1024.0f) + eps); }
        asm volatile("s_waitcnt lgkmcnt(0)" ::: "memory"); __builtin_amdgcn_s_barrier(); asm volatile("" ::: "memory");
    }
};
struct EpiWo {
    static constexpr bool PERM = true, AFTER_DRAIN = false;
    const float* x; bf16_t* h1b; bf16_t* xn; const float* g_post; const float* g_pre; PanelSumsq st1, st2; PG8_LAS unsigned char* lds;
    __device__ __forceinline__ void operator()(f32x4 (&acc)[2][2][4][2], const Unit& u, int wr, int wc, int fr, int fq) const {
        const int wid = wr * 4 + wc, lane = fq * 16 + fr;
        const PG8_LAS float* S = (const PG8_LAS float*)(lds + 4096);
        const int col0 = u.pn * 256 + wc * 32 + 8 * fq;
        st1.publish(acc, u, wr, wc, fr, fq, lds, wid, lane);
        f32x4 X0[3][2][2];
#pragma unroll
        for (int m = 0; m < 3; ++m) { const size_t off = (size_t)(u.pm * 256 + wr * 64 + m * 16 + fr) * DM + col0;
#pragma unroll
            for (int bj = 0; bj < 2; ++bj)
#pragma unroll
                for (int n = 0; n < 2; ++n) X0[m][bj][n] = *(const f32x4*)(x + off + bj * 128 + n * 4); }
        st1.finish(u, lds, wid, lane);
#pragma unroll
        for (int ai = 0; ai < 2; ++ai)
#pragma unroll
            for (int m = 0; m < 4; ++m) { const int r = ai * 128 + wr * 64 + m * 16 + fr; const float rs = S[r]; const size_t off = (size_t)(u.pm * 256 + r) * DM + col0;
#pragma unroll
                for (int bj = 0; bj < 2; ++bj)
#pragma unroll
                    for (int n = 0; n < 2; ++n) { const f32x4 xv = (ai == 0 && m < 3) ? X0[m < 3 ? m : 0][bj][n] : *(const f32x4*)(x + off + bj * 128 + n * 4); const f32x4 g = *(const f32x4*)(g_post + col0 + bj * 128 + n * 4);
                        acc[ai][bj][m][n] = xv + acc[ai][bj][m][n] * rs * g; }
                asm volatile("" : "+v"(acc[ai][0][m][0]), "+v"(acc[ai][0][m][1]), "+v"(acc[ai][1][m][0]), "+v"(acc[ai][1][m][1]));
                if (m & 1) asm volatile("" ::: "memory"); }
        st2.publish(acc, u, wr, wc, fr, fq, lds, wid, lane);
#pragma unroll
        for (int ai = 0; ai < 2; ++ai)
#pragma unroll
            for (int m = 0; m < 4; ++m) { const size_t off = (size_t)(u.pm * 256 + ai * 128 + wr * 64 + m * 16 + fr) * DM + col0;
#pragma unroll
                for (int bj = 0; bj < 2; ++bj) { const f32x4 h0 = acc[ai][bj][m][0], h1 = acc[ai][bj][m][1];
                    u32x4 hw; hw.x = pk2(h0[0], h0[1]); hw.y = pk2(h0[2], h0[3]); hw.z = pk2(h1[0], h1[1]); hw.w = pk2(h1[2], h1[3]); *(u32x4*)(h1b + off + bj * 128) = hw; } }
        st2.finish(u, lds, wid, lane);
#pragma unroll
        for (int ai = 0; ai < 2; ++ai)
#pragma unroll
            for (int m = 0; m < 4; ++m) { const int r = ai * 128 + wr * 64 + m * 16 + fr; const float rs = S[r]; const size_t off = (size_t)(u.pm * 256 + r) * DM + col0;
#pragma unroll
                for (int bj = 0; bj < 2; ++bj) { const f32x4 h0 = acc[ai][bj][m][0], h1 = acc[ai][bj][m][1];
                    const f32x4 g0 = *(const f32x4*)(g_pre + col0 + bj * 128), g1 = *(const f32x4*)(g_pre + col0 + bj * 128 + 4); const f32x4 o0 = h0 * rs * g0, o1 = h1 * rs * g1;
                    u32x4 w; w.x = pk2(o0[0], o0[1]); w.y = pk2(o0[2], o0[3]); w.z = pk2(o1[0], o1[1]); w.w = pk2(o1[2], o1[3]); *(u32x4*)(xn + off + bj * 128) = w; }
                asm volatile("" ::: "memory"); }
    }
};
struct EpiDown {
    static constexpr bool PERM = true, AFTER_DRAIN = false;
    const bf16_t* res; bf16_t* xn; const float* g; PanelSumsq st; PG8_LAS unsigned char* lds;
    __device__ __forceinline__ void operator()(f32x4 (&acc)[2][2][4][2], const Unit& u, int wr, int wc, int fr, int fq) const {
        const int wid = wr * 4 + wc, lane = fq * 16 + fr;
        const PG8_LAS float* S = (const PG8_LAS float*)(lds + 4096);
        const int col0 = u.pn * 256 + wc * 32 + 8 * fq;
        st.publish(acc, u, wr, wc, fr, fq, lds, wid, lane);
        u32x4 R[2][4][2];
#pragma unroll
        for (int ai = 0; ai < 2; ++ai)
#pragma unroll
            for (int m = 0; m < 4; ++m) { const size_t off = (size_t)(u.pm * 256 + ai * 128 + wr * 64 + m * 16 + fr) * DM + col0;
#pragma unroll
                for (int bj = 0; bj < 2; ++bj) R[ai][m][bj] = *(const u32x4*)(res + off + bj * 128); }
        st.finish(u, lds, wid, lane);
#pragma unroll
        for (int ai = 0; ai < 2; ++ai)
#pragma unroll
            for (int m = 0; m < 4; ++m) { const int r = ai * 128 + wr * 64 + m * 16 + fr; const float rs = S[r]; const size_t off = (size_t)(u.pm * 256 + r) * DM + col0;
#pragma unroll
                for (int bj = 0; bj < 2; ++bj) { const f32x4 g0 = *(const f32x4*)(g + col0 + bj * 128), g1 = *(const f32x4*)(g + col0 + bj * 128 + 4);
                    float hv[8]; unpack8(R[ai][m][bj], hv);
                    const f32x4 a0 = acc[ai][bj][m][0] * rs * g0, a1 = acc[ai][bj][m][1] * rs * g1; float o[8];
#pragma unroll
                    for (int e = 0; e < 4; ++e) { o[e] = hv[e] + a0[e]; o[4 + e] = hv[4 + e] + a1[e]; }
                    *(u32x4*)(xn + off + bj * 128) = pack8(o); } }
    }
};
struct EpiPe {
    static constexpr bool PERM = true, AFTER_DRAIN = false;
    bf16_t* O; float* rowss;
    __device__ __forceinline__ void operator()(const f32x4 (&acc)[2][2][4][2], const Unit& u, int wr, int wc, int fr, int fq) const {
        const int row0 = u.pm * 256 + wr * 64 + fr, c0 = u.pn * 256 + wc * 32 + 8 * fq;
#pragma unroll
        for (int ai = 0; ai < 2; ++ai)
#pragma unroll
            for (int m = 0; m < 4; ++m) { const int row = row0 + ai * 128 + m * 16; float q = 0.f;
#pragma unroll
                for (int bj = 0; bj < 2; ++bj) { const f32x4 v0 = acc[ai][bj][m][0], v1 = acc[ai][bj][m][1]; u32x4 w;
                    q += (v0[0] * v0[0] + v0[1] * v0[1]) + (v0[2] * v0[2] + v0[3] * v0[3]) + (v1[0] * v1[0] + v1[1] * v1[1]) + (v1[2] * v1[2] + v1[3] * v1[3]);
                    w.x = pk2(v0[0], v0[1]); w.y = pk2(v0[2], v0[3]); w.z = pk2(v1[0], v1[1]); w.w = pk2(v1[2], v1[3]);
                    *(u32x4*)(O + (long)row * DM + c0 + bj * 128) = w; }
                q += __shfl_xor(q, 16); q += __shfl_xor(q, 32);
                if (fq == 0) atomicAdd(rowss + row, q); }
    }
};
struct EpiOut {
    static constexpr bool PERM = true, AFTER_DRAIN = false;
    float* out; const bf16_t* h2b; const bf16_t* pe; const float* rowss; const float* gple;
    __device__ __forceinline__ void operator()(const f32x4 (&acc)[2][2][4][2], const Unit& u, int wr, int wc, int fr, int fq) const {
        const int row0 = u.pm * 256 + wr * 64 + fr, c0 = u.pn * 256 + wc * 32 + 8 * fq;
#pragma unroll
        for (int bj = 0; bj < 2; ++bj) { const int c = c0 + bj * 128;
            const f32x4 ga = *(const f32x4*)(gple + c), gb = *(const f32x4*)(gple + c + 4);
#pragma unroll
            for (int ai = 0; ai < 2; ++ai) {
            u32x4 H[4], Q[4]; float R[4];
#pragma unroll
            for (int m = 0; m < 4; ++m) { const int row = row0 + ai * 128 + m * 16;
                H[m] = *(const u32x4*)(h2b + (long)row * DM + c); Q[m] = *(const u32x4*)(pe + (long)row * DM + c); R[m] = rowss[row]; }
            __builtin_amdgcn_sched_barrier(0);
#pragma unroll
            for (int m = 0; m < 4; ++m) { const int row = row0 + ai * 128 + m * 16; const float r = __builtin_amdgcn_rsqf(R[m] * (1.0f / DM) + EPS);
                float hv[8], pv[8]; unpack8(H[m], hv); unpack8(Q[m], pv);
                const f32x4 v0 = acc[ai][bj][m][0], v1 = acc[ai][bj][m][1]; f32x4 o0, o1;
#pragma unroll
                for (int e = 0; e < 4; e += 2) { const f32x2 s0 = fast_sigmoid2((f32x2){v0[e], v0[e + 1]}), s1 = fast_sigmoid2((f32x2){v1[e], v1[e + 1]});
                    const f32x2 e0 = (f32x2){pv[e], pv[e + 1]} * r * (f32x2){ga[e], ga[e + 1]}, e1 = (f32x2){pv[4 + e], pv[5 + e]} * r * (f32x2){gb[e], gb[e + 1]};
                    const f32x2 q0 = (f32x2){hv[e], hv[e + 1]} + s0 * e0, q1 = (f32x2){hv[4 + e], hv[5 + e]} + s1 * e1;
                    o0[e] = q0.x; o0[e + 1] = q0.y; o1[e] = q1.x; o1[e + 1] = q1.y; }
                float* op = out + (long)row * DM + c; *(f32x4*)op = o0; *(f32x4*)(op + 4) = o1; } } }
    }
};
template <class Epi>
__device__ __forceinline__ void run_gemm_fused(LAS unsigned char* lds, const bf16_t* A, const bf16_t* Bt, int K, int G, int c, const Epi& E) {
    pg8::Gemm g{A, Bt, 16384, DM, K}; pg8::StaticOrder S; S.init(16384, DM, G, c);
    pg8::gemm_phase<Epi, pg8::StaticOrder, false, true>(lds, g, S, E);
    __syncthreads();
}

template <class Epi>
__device__ __forceinline__ void run_gemm(LAS unsigned char* lds, const bf16_t* A, const bf16_t* Bt, int M, int N, int K, int G, int c, const Epi& E) {
    pg8::Gemm g{A, Bt, M, N, K}; pg8::StaticOrder S; S.init(M, N, G, c);
    pg8::gemm_phase<Epi, pg8::StaticOrder, true, true>(lds, g, S, E);
    __syncthreads();
}

__device__ __forceinline__ int src_col(int mode, int n) {
    if (mode == 1) { const int h = n / 96, w = n % 96; if (w < 64) return n; const int j = w - 64; return h * 96 + 64 + 16 * (j & 1) + (j >> 1); }
    if (mode == 2) return (n >> 6) * 128 + (n & 63);
    if (mode == 3) return (n >> 6) * 128 + 64 + (n & 63);
    if (mode == 4) return (n >> 8) * 128 + (n & 127);
    if (mode == 5) { if (n < 672) return n; if (n < 768) return -1; const int e = n - 768, k = e >> 8, w = e & 255; return 672 + (w >= 128 ? 512 : 0) + 128 * k + (w & 127); }
    return n;
}
__device__ __forceinline__ void transpose_item(const float* W, int K, int Nsrc, int Ndst, bf16_t* WT, LAS float* scr, int item, int lane, int mode, float mul = 1.0f) {
    const int nblk = Ndst / 32, kb = item / nblk, nb = item % nblk, k0 = 64 * kb, n0 = 32 * nb;
    const int sc = src_col(mode, n0 + (lane & 31));
    float tv[32];
#pragma unroll
    for (int i = 0; i < 32; ++i) { const int kk = 2 * i + (lane >> 5); tv[i] = sc >= 0 ? __builtin_nontemporal_load(W + (size_t)(k0 + kk) * Nsrc + sc) : 0.f; }
#pragma unroll
    for (int i = 0; i < 32; ++i) { const int kk = 2 * i + (lane >> 5); scr[kk * 33 + (lane & 31)] = tv[i] * mul; }
    asm volatile("s_waitcnt lgkmcnt(0)" ::: "memory");
    const int c = lane & 7;
#pragma unroll
    for (int j = 0; j < 4; ++j) { const int n = (lane >> 3) + 8 * j; const LAS float* s = scr + (8 * c) * 33 + n;
        u32x4 o; o.x = pk2(s[0 * 33], s[1 * 33]); o.y = pk2(s[2 * 33], s[3 * 33]); o.z = pk2(s[4 * 33], s[5 * 33]); o.w = pk2(s[6 * 33], s[7 * 33]);
        *(u32x4*)(WT + (size_t)(n0 + n) * K + k0 + 8 * c) = o; }
    asm volatile("s_waitcnt lgkmcnt(0)" ::: "memory");
}
__device__ __forceinline__ void load_row_f32(const float* rp, int lane, float (&v)[16]) {
#pragma unroll
    for (int j = 0; j < 2; ++j) { const f32x4 a = *(const f32x4*)(rp + 512 * j + 8 * lane), b = *(const f32x4*)(rp + 512 * j + 8 * lane + 4);
#pragma unroll
        for (int e = 0; e < 4; ++e) { v[8 * j + e] = a[e]; v[8 * j + 4 + e] = b[e]; } }
}
__device__ __forceinline__ void load_row_bf16(const bf16_t* rp, int lane, float (&v)[16]) {
#pragma unroll
    for (int j = 0; j < 2; ++j) { const u32x4 w = *(const u32x4*)(rp + 512 * j + 8 * lane); float f[8]; unpack8(w, f);
#pragma unroll
        for (int e = 0; e < 8; ++e) v[8 * j + e] = f[e]; }
}
__device__ __forceinline__ void store_row_bf16(bf16_t* rp, int lane, const float (&v)[16]) {
#pragma unroll
    for (int j = 0; j < 2; ++j) { float f[8];
#pragma unroll
        for (int e = 0; e < 8; ++e) f[e] = v[8 * j + e];
        *(u32x4*)(rp + 512 * j + 8 * lane) = pack8(f); }
}
__device__ __forceinline__ void store_row_f32(float* rp, int lane, const float (&v)[16]) {
#pragma unroll
    for (int j = 0; j < 2; ++j) { f32x4 a, b;
#pragma unroll
        for (int e = 0; e < 4; ++e) { a[e] = v[8 * j + e]; b[e] = v[8 * j + 4 + e]; }
        *(f32x4*)(rp + 512 * j + 8 * lane) = a; *(f32x4*)(rp + 512 * j + 8 * lane + 4) = b; }
}
__device__ __forceinline__ float sumsq16(const float (&v)[16]) { float s = 0.f;
#pragma unroll
    for (int e = 0; e < 16; ++e) s += v[e] * v[e];
    return s; }

__device__ __forceinline__ void phase_prologue(const Params& P, LAS unsigned char* lds, int vcu, int G, int wave, int lane) {
    unsigned char* ws = P.ws;
    LAS float* scr = (LAS float*)(lds + wave * 16384);
    const int gw = vcu * 8 + wave, NGW = G * 8;
    const int gt = gw * 64 + lane, NGT = NGW * 64;
    const int gw4 = vcu * 4 + (wave & 3), NGW4 = G * 4, gt4 = gw4 * 64 + lane, NGT4 = NGW4 * 64;
    if (wave >= 4) {
    constexpr int I0 = 16 * 56, I1 = 6 * 24, I2 = 4 * 16, I3 = 4 * 16, I4 = 16 * 32, I5 = 16 * 176, I6 = 0, I7 = 44 * 32, I8 = 4 * 32, I9 = 16 * 32;
    constexpr int NITEMS = I0 + I1 + I2 + I3 + I4 + I5 + I6 + I7 + I8 + I9;
    for (int it = gw4; it < NITEMS; it += NGW4) {
        int r = it;
        if (r < I0) { transpose_item(P.w_in, DM, NPROJ, NPROJ_P, (bf16_t*)(ws + WS_WIN), scr, r, lane, 5); continue; } r -= I0;
        if (r < I1) { transpose_item(P.w_q_b, QL, NQ, NQ, (bf16_t*)(ws + WS_WQ), scr, r, lane, 1, QSCALE); continue; } r -= I1;
        if (r < I2) { transpose_item(P.w_kv_b, KVL, 1024, 512, (bf16_t*)(ws + WS_WK), scr, r, lane, 2); continue; } r -= I2;
        if (r < I3) { transpose_item(P.w_kv_b, KVL, 1024, 512, (bf16_t*)(ws + WS_WV), scr, r, lane, 3); continue; } r -= I3;
        if (r < I4) { transpose_item(P.w_o, DM, DM, DM, (bf16_t*)(ws + WS_WO), scr, r, lane, 0); continue; } r -= I4;
        if (r < I5) { const int nb = r % 176; transpose_item((nb & 4) ? P.w_up : P.w_gate, DM, DFF, 2 * DFF, (bf16_t*)(ws + WS_WG), scr, r, lane, 4); continue; } r -= I5;
        if (r < I7) { transpose_item(P.w_down, DFF, DM, DM, (bf16_t*)(ws + WS_WD), scr, r, lane, 0); continue; } r -= I7;
        if (r < I8) { transpose_item(P.w_ple_proj, PLE, DM, DM, (bf16_t*)(ws + WS_WPP), scr, r, lane, 0); continue; } r -= I8;
        transpose_item(P.w_ple_gate, DM, DM, DM, (bf16_t*)(ws + WS_WPG), scr, r, lane, 0);
    }
    { float* cs = (float*)(ws + WS_CS);
      for (int i = gt4; i < TT * 16; i += NGT4) { const int t = i >> 4, k = i & 15;
          const float inv = exp2f(-(float)k * (13.287712379549449f / 16.0f));
          const float ang = (float)P.pos[t] * inv;
          const double rev = (double)ang * 0.15915494309189535; const float fr = (float)(rev - floor(rev));
          cs[2 * (size_t)i] = __builtin_amdgcn_cosf(fr); cs[2 * (size_t)i + 1] = __builtin_amdgcn_sinf(fr); } }
    }
    { constexpr int XN_SPLIT = 27648; const int lo = wave < 4 ? 0 : XN_SPLIT, hi_ = wave < 4 ? XN_SPLIT : TT;
      f32x4 g[4];
#pragma unroll
      for (int j = 0; j < 4; ++j) g[j] = *(const f32x4*)(P.g_mix_pre + 4 * lane + 256 * j);
      bf16_t* XB = (bf16_t*)(ws + WS_XB);
      for (int m = lo + gw4; m < hi_; m += 4 * NGW4) { f32x4 v[4][4];
#pragma unroll
          for (int u = 0; u < 4; ++u) { const int mm = m + u * NGW4 < hi_ ? m + u * NGW4 : m;
#pragma unroll
              for (int j = 0; j < 4; ++j) v[u][j] = __builtin_nontemporal_load((const f32x4*)(P.x + (size_t)mm * DM + 4 * lane + 256 * j)); }
#pragma unroll
          for (int u = 0; u < 4; ++u) { const int mm = m + u * NGW4; float ss = 0.f;
#pragma unroll
              for (int j = 0; j < 4; ++j) ss += (v[u][j][0] * v[u][j][0] + v[u][j][1] * v[u][j][1]) + (v[u][j][2] * v[u][j][2] + v[u][j][3] * v[u][j][3]);
              const float rstd = __builtin_amdgcn_rsqf(wave_sum(ss) * (1.0f / DM) + EPS);
              if (mm < hi_) {
#pragma unroll
                  for (int j = 0; j < 4; ++j) { const f32x4 o = v[u][j] * rstd * g[j]; u32x2 w; w.x = pk2(o[0], o[1]); w.y = pk2(o[2], o[3]);
                      __builtin_nontemporal_store(w, (u32x2*)(XB + (size_t)mm * DM + 4 * lane + 256 * j)); } } } } }
    { const f32x4* pp = (const f32x4*)P.p; u32x2* pb = (u32x2*)(ws + WS_PBF); constexpr int NCH = TT * PLE / 4;
      for (int i = gt; i < NCH; i += 4 * NGT) { f32x4 a[4];
#pragma unroll
          for (int u = 0; u < 4; ++u) a[u] = __builtin_nontemporal_load(pp + (i + u * NGT < NCH ? i + u * NGT : i));
#pragma unroll
          for (int u = 0; u < 4; ++u) if (i + u * NGT < NCH) { u32x2 o; o.x = pk2(a[u][0], a[u][1]); o.y = pk2(a[u][2], a[u][3]); __builtin_nontemporal_store(o, pb + i + u * NGT); } } }
}

__device__ __forceinline__ void phase_r1(const Params& P, LAS unsigned char* lds, int vcu, int G, int tid, int wave, int lane) {
    unsigned char* ws = P.ws;
    const bf16_t* proj = (const bf16_t*)(ws + WS_PROJ);
    bf16_t* qan = (bf16_t*)(ws + WS_QAN); bf16_t* kvan = (bf16_t*)(ws + WS_KVAN); bf16_t* Kb = (bf16_t*)(ws + WS_K); bf16_t* cat = (bf16_t*)(ws + WS_CAT);
    const float* cs = (const float*)(ws + WS_CS);
    LAS float* cbuf = (LAS float*)lds;
    for (int ch = vcu; ch < TT / 128; ch += G) {
        const int t0 = ch * 128;
        { const bool has_halo = (t0 & (SEQ - 1)) != 0;
#define R1_BAR() do { asm volatile("s_waitcnt lgkmcnt(0)" ::: "memory"); __builtin_amdgcn_s_barrier(); asm volatile("" ::: "memory"); } while (0)
          if (wave < 4) {
              const int tc = tid;
              f32x2 w2[CONVW];
              { const float* wp = P.conv_w + 2 * tc;
#pragma unroll
                for (int j = 0; j < CONVW; ++j) { w2[j] = *(const f32x2*)wp; wp += CONVC; asm volatile("" : "+v"(wp)); } }
              const f32x2 bias2 = *(const f32x2*)(P.conv_b + 2 * tc);
              const unsigned* pg = (const unsigned*)((const bf16_t*)(ws + WS_GLU) + 2 * tc);
              f32x2 win[38];
              { unsigned hv[30];
#pragma unroll
                for (int j = 0; j < 30; ++j) hv[j] = pg[(size_t)(has_halo ? t0 - 30 + j : t0) * (CONVC / 2)];
#pragma unroll
                for (int j = 0; j < 30; ++j) win[j] = has_halo ? (f32x2){bf_lo(hv[j]), bf_hi(hv[j])} : (f32x2){0.f, 0.f}; }
              unsigned nv[4][8];
#pragma unroll
              for (int q = 0; q < 4; ++q)
#pragma unroll
                  for (int u = 0; u < 8; ++u) nv[q][u] = pg[(size_t)(t0 + 8 * q + u) * (CONVC / 2)];
#define R1_STEP(g, sl) do { const int tg = t0 + 8 * (g); \
                  _Pragma("unroll") for (int u = 0; u < 8; ++u) win[30 + u] = (f32x2){bf_lo(nv[sl][u]), bf_hi(nv[sl][u])}; \
                  if ((g) + 4 < 16) { _Pragma("unroll") for (int u = 0; u < 8; ++u) nv[sl][u] = pg[(size_t)(tg + 32 + u) * (CONVC / 2)]; } \
                  LAS float* cb = cbuf + ((g) & 1) * 4096; \
                  _Pragma("unroll") for (int u = 0; u < 8; u += 2) { f32x2 a2 = bias2, b2 = bias2; \
                      _Pragma("unroll") for (int j = 0; j < CONVW; ++j) { a2 += w2[j] * win[u + j]; b2 += w2[j] * win[u + 1 + j]; } \
                      *(LAS f32x2*)(cb + u * 512 + 2 * tc) = a2; *(LAS f32x2*)(cb + (u + 1) * 512 + 2 * tc) = b2; __builtin_amdgcn_sched_barrier(0); } \
                  _Pragma("unroll") for (int j = 0; j < 30; ++j) win[j] = win[j + 8]; \
                  R1_BAR(); } while (0)
              for (int gb = 0; gb < 16; gb += 4) { R1_STEP(gb, 0); R1_STEP(gb + 1, 1); R1_STEP(gb + 2, 2); R1_STEP(gb + 3, 3); }
#undef R1_STEP
              R1_BAR();
          } else {
              float lg[8], lb[8], gq[8], gk[8];
#pragma unroll
              for (int e = 0; e < 8; ++e) { lg[e] = P.conv_ln_g[8 * lane + e]; lb[e] = P.conv_ln_b[8 * lane + e]; gq[e] = lane < 48 ? P.g_q_a[8 * lane + e] : 0.f; gk[e] = lane < 32 ? P.g_kv_a[8 * lane + e] : 0.f; }
              const int tb = t0 + (wave - 4) * 32;
              u32x4 bq[4][2], bk[4][2]; bf16_t b1[4][2], b2[4][2]; float bc[4][2], bs[4][2];
#define R1_BLOAD(sl, g) do { _Pragma("unroll") for (int k = 0; k < 2; ++k) { const int t = tb + 2 * (g) + k; const bf16_t* pr = proj + (size_t)t * PROJ_LD; const u32x4 z = {0u, 0u, 0u, 0u}; \
                      bq[sl][k] = lane < 48 ? *(const u32x4*)(pr + 8 * lane) : z; bk[sl][k] = lane < 32 ? *(const u32x4*)(pr + QL + 8 * lane) : z; \
                      b1[sl][k] = lane < 16 ? pr[QL + KVL + lane] : (bf16_t)0; b2[sl][k] = lane < 16 ? pr[QL + KVL + 16 + lane] : (bf16_t)0; \
                      bc[sl][k] = lane < 16 ? cs[((size_t)t * 16 + lane) * 2] : 0.f; bs[sl][k] = lane < 16 ? cs[((size_t)t * 16 + lane) * 2 + 1] : 0.f; } } while (0)
#define R1_BCOMP(sl, g) do { _Pragma("unroll") for (int k = 0; k < 2; ++k) { const int t = tb + 2 * (g) + k; \
                      float fq[8], fk[8]; unpack8(bq[sl][k], fq); unpack8(bk[sl][k], fk); float sq = 0.f, sk = 0.f; \
                      _Pragma("unroll") for (int e = 0; e < 8; ++e) { sq += fq[e] * fq[e]; sk += fk[e] * fk[e]; } \
                      const float rq = __builtin_amdgcn_rsqf(wave_sum(sq) * (1.0f / QL) + EPS), rk = __builtin_amdgcn_rsqf(wave_sum(sk) * (1.0f / KVL) + EPS); \
                      _Pragma("unroll") for (int e = 0; e < 8; ++e) { fq[e] = fq[e] * rq * gq[e]; fk[e] = fk[e] * rk * gk[e]; } \
                      if (lane < 48) *(u32x4*)(qan + (size_t)t * QL + 8 * lane) = pack8(fq); \
                      if (lane < 32) *(u32x4*)(kvan + (size_t)t * KVL + 8 * lane) = pack8(fk); \
                      { const float x1 = bf1(b1[sl][k]), x2 = bf1(b2[sl][k]); const unsigned o = pk2(x1 * bc[sl][k] - x2 * bs[sl][k], x1 * bs[sl][k] + x2 * bc[sl][k]); \
                        const int sh = 4 * (lane & 3); u32x4 kv4; \
                        kv4.x = (unsigned)__shfl((int)o, sh); kv4.y = (unsigned)__shfl((int)o, sh + 1); kv4.z = (unsigned)__shfl((int)o, sh + 2); kv4.w = (unsigned)__shfl((int)o, sh + 3); \
                        if (lane < 32) *(u32x4*)(Kb + (size_t)t * NQ + (lane >> 2) * 96 + 64 + 2 * sh) = kv4; } } } while (0)
#define R1_LN(gp) do { const LAS float* cb = cbuf + ((gp) & 1) * 4096; \
                  _Pragma("unroll") for (int k = 0; k < 2; ++k) { const int u = (wave - 4) * 2 + k; \
                      const LAS f32x4* rp = (const LAS f32x4*)(cb + u * 512 + 8 * lane); const f32x4 a = rp[0], b4 = rp[1]; float v[8]; \
                      _Pragma("unroll") for (int e = 0; e < 4; ++e) { v[e] = a[e]; v[4 + e] = b4[e]; } \
                      float sm = 0.f; _Pragma("unroll") for (int e = 0; e < 8; ++e) sm += v[e]; \
                      const float mean = wave_sum(sm) * (1.0f / CONVC); float q = 0.f; \
                      _Pragma("unroll") for (int e = 0; e < 8; ++e) { v[e] -= mean; q += v[e] * v[e]; } \
                      const float rstd = __builtin_amdgcn_rsqf(wave_sum(q) * (1.0f / CONVC) + EPS); \
                      _Pragma("unroll") for (int e = 0; e < 8; ++e) { const float y = v[e] * rstd * lg[e] + lb[e]; v[e] = y * fast_sigmoid(y); } \
                      *(u32x4*)(cat + (size_t)(t0 + 8 * (gp) + u) * DM + 512 + 8 * lane) = pack8(v); } } while (0)
#define R1_LSTEP(g, sl) do { if ((g) >= 1) R1_LN((g) - 1); R1_BCOMP(sl, g); if ((g) + 4 < 16) R1_BLOAD(sl, (g) + 4); R1_BAR(); } while (0)
              R1_BLOAD(0, 0); R1_BLOAD(1, 1); R1_BLOAD(2, 2); R1_BLOAD(3, 3);
              for (int gb = 0; gb < 16; gb += 4) { R1_LSTEP(gb, 0); R1_LSTEP(gb + 1, 1); R1_LSTEP(gb + 2, 2); R1_LSTEP(gb + 3, 3); }
              R1_LN(15); R1_BAR();
#undef R1_LSTEP
#undef R1_LN
#undef R1_BCOMP
#undef R1_BLOAD
          }
#undef R1_BAR
          __syncthreads();
        }
    }
}

constexpr int KROW = 208, VROW = 144, KBUF = 64 * KROW, VBUF = 64 * VROW, ABUF = KBUF + VBUF;
constexpr float ATT_THR = 8.0f;
__device__ __forceinline__ int crow(int r, int hi) { return (r & 3) + 8 * (r >> 2) + 4 * hi; }
__device__ __forceinline__ float max3f(float a, float b, float c) { return fmaxf(fmaxf(a, b), c); }
template <bool PRE>
__device__ __forceinline__ float attn_half(f32x16& c, const f32x16& b, f32x16& n, f32x16& o0, f32x16& o1, float& lsum, const LAS unsigned char* kn, const LAS unsigned char* kn2, const LAS unsigned char* vb,
                                           const bf16x8 (&qr)[6], const f32x16& negm, bf16x8& f0, bf16x8& f1) {
    float ps = 0.f, mxb;
    bf16x8 f2, va0, va1, vb0, vb1;
#define ATT_EXP(r) do { c[r] = __builtin_amdgcn_exp2f(c[r]); ps += c[r]; } while (0)
#define ATT_KRD(dst, d0) do { dst = *(const LAS bf16x8*)(kn + (d0) * 32); } while (0)
#define ATT_QKC(src, d0) do { n = __builtin_amdgcn_mfma_f32_32x32x16_bf16(src, qr[d0], (d0) == 0 ? negm : n, 0, 0, 0); } while (0)
#define ATT_FENCE() __builtin_amdgcn_sched_barrier(0)
    ATT_KRD(f2, 2); ATT_FENCE(); ATT_QKC(f0, 0); ATT_EXP(0); ATT_EXP(1); ATT_EXP(2); mxb = max3f(b[0], b[1], b[2]); mxb = max3f(mxb, b[3], b[4]); ATT_FENCE();
    ATT_KRD(f0, 3); ATT_FENCE(); ATT_QKC(f1, 1); ATT_EXP(3); ATT_EXP(4); ATT_EXP(5); mxb = max3f(mxb, b[5], b[6]); mxb = max3f(mxb, b[7], b[8]); ATT_FENCE();
    ATT_KRD(f1, 4); ATT_FENCE(); ATT_QKC(f2, 2); ATT_EXP(6); ATT_EXP(7); ATT_EXP(8); mxb = max3f(mxb, b[9], b[10]); ATT_FENCE();
    ATT_KRD(f2, 5); va0 = *(const LAS bf16x8*)(vb); va1 = *(const LAS bf16x8*)(vb + 32 * VROW); ATT_FENCE(); ATT_QKC(f0, 3); ATT_EXP(9); ATT_EXP(10); ATT_EXP(11); mxb = max3f(mxb, b[11], b[12]); ATT_FENCE();
    vb0 = *(const LAS bf16x8*)(vb + 32); vb1 = *(const LAS bf16x8*)(vb + 32 * VROW + 32); if (PRE) f0 = *(const LAS bf16x8*)(kn2); ATT_FENCE(); ATT_QKC(f1, 4); ATT_EXP(12); ATT_EXP(13); mxb = max3f(mxb, b[13], b[14]); ATT_FENCE();
    if (PRE) f1 = *(const LAS bf16x8*)(kn2 + 32); ATT_FENCE(); ATT_QKC(f2, 5); ATT_EXP(14); ATT_EXP(15); mxb = fmaxf(mxb, b[15]); ATT_FENCE();
#undef ATT_EXP
#undef ATT_KRD
#undef ATT_QKC
    lsum += ps;
    const float mxo = __shfl_xor(mxb, 32);
    { u32x4 pw; pw.x = pk2(c[0], c[1]); pw.y = pk2(c[2], c[3]); pw.z = pk2(c[4], c[5]); pw.w = pk2(c[6], c[7]); const bf16x8 pb = __builtin_bit_cast(bf16x8, pw);
      o0 = __builtin_amdgcn_mfma_f32_32x32x16_bf16(va0, pb, o0, 0, 0, 0); o1 = __builtin_amdgcn_mfma_f32_32x32x16_bf16(va1, pb, o1, 0, 0, 0); ATT_FENCE(); }
    { u32x4 pw; pw.x = pk2(c[8], c[9]); pw.y = pk2(c[10], c[11]); pw.z = pk2(c[12], c[13]); pw.w = pk2(c[14], c[15]); const bf16x8 pb = __builtin_bit_cast(bf16x8, pw);
      o0 = __builtin_amdgcn_mfma_f32_32x32x16_bf16(vb0, pb, o0, 0, 0, 0); o1 = __builtin_amdgcn_mfma_f32_32x32x16_bf16(vb1, pb, o1, 0, 0, 0); ATT_FENCE(); }
#undef ATT_FENCE
    return fmaxf(mxb, mxo);
}
__device__ __forceinline__ void attn_unit(int b, int h, int qb, const bf16_t* Q, const bf16_t* K, const bf16_t* Vt, const float* cs, bf16_t* O, LAS unsigned char* lds, int tid, int wid, int lane) {
    const int r32 = lane & 31, hi = lane >> 5;
    const int q0 = qb * 256, qrow = q0 + wid * 32 + r32; const long tok = (long)b * SEQ + qrow;
    bf16x8 qr[6];
#pragma unroll
    for (int d0 = 0; d0 < 6; ++d0) qr[d0] = *(const bf16x8*)(Q + tok * NQ + h * 96 + d0 * 16 + hi * 8);
#pragma unroll
    for (int d0 = 4; d0 < 6; ++d0) { const int i0 = 8 * (d0 - 4) + 4 * hi; const f32x4* tp = (const f32x4*)(cs + (tok * 16 + i0) * 2); const f32x4 a = tp[0], c = tp[1];
        float f[8]; unpack8(__builtin_bit_cast(u32x4, qr[d0]), f); float g[8];
        g[0] = f[0] * a[0] - f[1] * a[1]; g[1] = f[0] * a[1] + f[1] * a[0]; g[2] = f[2] * a[2] - f[3] * a[3]; g[3] = f[2] * a[3] + f[3] * a[2];
        g[4] = f[4] * c[0] - f[5] * c[1]; g[5] = f[4] * c[1] + f[5] * c[0]; g[6] = f[6] * c[2] - f[7] * c[3]; g[7] = f[6] * c[3] + f[7] * c[2];
        qr[d0] = __builtin_bit_cast(bf16x8, pack8(g)); }
    const bf16_t* Kh = K + (long)b * SEQ * NQ + h * 96;
    const bf16_t* Vh = Vt + ((long)b * 512 + h * 64) * SEQ;
    const int kr0 = tid / 12, kc0 = tid % 12, kr1 = (tid + 512) / 12, kc1 = (tid + 512) % 12; const bool k1 = tid < 256;
    const int vr = tid >> 3, vc = tid & 7;
    unsigned kvo0 = (unsigned)(kr0 * NQ + kc0 * 8) * 2u, kvo1 = (unsigned)(kr1 * NQ + kc1 * 8) * 2u, vvo = (unsigned)(vr * SEQ + vc * 8) * 2u;
    unsigned ksto0 = (unsigned)(kr0 * KROW + kc0 * 16), ksto1 = (unsigned)(kr1 * KROW + kc1 * 16), vsto = (unsigned)(KBUF + vr * VROW + (vc >> 1) * 32 + (vc & 1) * 8);
    unsigned kbase = (unsigned)(r32 * KROW + hi * 16), vbase = (unsigned)(KBUF + r32 * VROW + hi * 16);
    asm volatile("" : "+v"(kvo0), "+v"(kvo1), "+v"(vvo), "+v"(ksto0), "+v"(ksto1), "+v"(vsto), "+v"(kbase), "+v"(vbase));
    const int NT = 4 * (qb + 1);
    u32x4 sk0, sk1 = {0u, 0u, 0u, 0u}, sv;
#define ATT_LOAD(t) do { const char* kt_ = (const char*)(Kh + (long)(64 * (t)) * NQ); const char* vt_ = (const char*)(Vh + 64 * (t)); \
        sk0 = *(const u32x4*)(kt_ + kvo0); if (k1) sk1 = *(const u32x4*)(kt_ + kvo1); sv = *(const u32x4*)(vt_ + vvo); } while (0)
#define ATT_STORE(boff) do { LAS unsigned char* kb_ = lds + (boff); *(LAS u32x4*)(kb_ + ksto0) = sk0; if (k1) *(LAS u32x4*)(kb_ + ksto1) = sk1; \
        { LAS unsigned char* vp_ = kb_ + vsto; u32x2 lo_ = {sv.x, sv.y}, hi_ = {sv.z, sv.w}; *(LAS u32x2*)vp_ = lo_; *(LAS u32x2*)(vp_ + 16) = hi_; } } while (0)
    ATT_LOAD(0); ATT_STORE(0);
    ATT_LOAD(1); ATT_STORE(ABUF);
    __syncthreads();
    f32x16 o0 = {}, o1 = {};
    float m_ref = 0.f, lsum = 0.f;
    const int wq_lo = q0 + wid * 32, wq_hi = wq_lo + 31;
    f32x16 pa, pb, pc, negm = {};
#define ATT_DECIDE(mx, X, Y) do { if (__any((mx) > ATT_THR)) { \
            const float d_ = fmaxf((mx), 0.f); const float alpha = __builtin_amdgcn_exp2f(-d_); m_ref += d_; lsum *= alpha; \
            _Pragma("unroll") for (int r = 0; r < 16; ++r) { o0[r] *= alpha; o1[r] *= alpha; X[r] -= d_; Y[r] -= d_; negm[r] = -m_ref; } } } while (0)
#define ATT_MASK(X, hs) do { if (32 * (hs) + 31 > wq_lo) { const int kv0 = 32 * (hs); \
            _Pragma("unroll") for (int r = 0; r < 16; ++r) { if (kv0 + crow(r, hi) > qrow) X[r] = -INFINITY; } } } while (0)
    { const f32x16 zero = {};
#pragma unroll
      for (int d0 = 0; d0 < 6; ++d0) { const bf16x8 a0 = *(const LAS bf16x8*)(lds + kbase + d0 * 32); pa = __builtin_amdgcn_mfma_f32_32x32x16_bf16(a0, qr[d0], d0 == 0 ? zero : pa, 0, 0, 0); }
#pragma unroll
      for (int d0 = 0; d0 < 6; ++d0) { const bf16x8 a0 = *(const LAS bf16x8*)(lds + kbase + 32 * KROW + d0 * 32); pb = __builtin_amdgcn_mfma_f32_32x32x16_bf16(a0, qr[d0], d0 == 0 ? zero : pb, 0, 0, 0); }
      ATT_MASK(pa, 0);
      float mx = fmaxf(pa[0], pa[1]);
#pragma unroll
      for (int r = 2; r < 16; r += 2) mx = max3f(mx, pa[r], pa[r + 1]);
      mx = fmaxf(mx, __shfl_xor(mx, 32));
      ATT_DECIDE(mx, pa, pb); }
#define ATT_HSTEP(C, B, N, hs, KN, KN2, VB, PRE) do { \
        if (32 * (hs) <= wq_hi) { \
            if (((hs) & 1) == 0) { kf0 = *(const LAS bf16x8*)(KN); kf1 = *(const LAS bf16x8*)((KN) + 32); } \
            const bool needb_ = 32 * ((hs) + 1) <= wq_hi; \
            if (needb_) ATT_MASK(B, (hs) + 1); \
            const float mx_ = attn_half<PRE>(C, B, N, o0, o1, lsum, (KN), (KN2), (VB), qr, negm, kf0, kf1); \
            if (needb_) ATT_DECIDE(mx_, B, N); \
        } } while (0)
#define ATT_TILE(t, CUR, NXT, NN, A0, A1, A2) do { \
        if ((t) + 2 < NT) ATT_LOAD((t) + 2); \
        ATT_HSTEP(A0, A1, A2, 2 * (t), lds + (NXT) * ABUF + kbase, lds + (NXT) * ABUF + kbase + 32 * KROW, lds + (CUR) * ABUF + vbase, true); \
        ATT_HSTEP(A1, A2, A0, 2 * (t) + 1, lds + (NXT) * ABUF + kbase + 32 * KROW, lds, lds + (CUR) * ABUF + vbase + 64, false); \
        if ((t) + 2 < NT) ATT_STORE((NN) * ABUF); \
        __syncthreads(); } while (0)
    bf16x8 kf0 = {}, kf1 = {};
    for (int t = 0; t < NT; t += 3) {
        ATT_TILE(t, 0, 1, 2, pa, pb, pc);
        if (t + 1 >= NT) break;
        ATT_TILE(t + 1, 1, 2, 0, pc, pa, pb);
        if (t + 2 >= NT) break;
        ATT_TILE(t + 2, 2, 0, 1, pb, pc, pa);
    }
#undef ATT_TILE
#undef ATT_HSTEP
#undef ATT_MASK
#undef ATT_DECIDE
#undef ATT_LOAD
#undef ATT_STORE
    lsum += __shfl_xor(lsum, 32);
    const float inv = 1.0f / lsum;
    bf16_t* op = O + tok * DM + h * 64;
#pragma unroll
    for (int g = 0; g < 4; ++g) {
        u32x2 a, d; a.x = pk2(o0[4 * g] * inv, o0[4 * g + 1] * inv); a.y = pk2(o0[4 * g + 2] * inv, o0[4 * g + 3] * inv);
        d.x = pk2(o1[4 * g] * inv, o1[4 * g + 1] * inv); d.y = pk2(o1[4 * g + 2] * inv, o1[4 * g + 3] * inv);
        *(u32x2*)(op + 8 * g + 4 * hi) = a; *(u32x2*)(op + 32 + 8 * g + 4 * hi) = d;
    }
}
__device__ __forceinline__ void phase_attn(const Params& P, LAS unsigned char* lds, int vcu, int G, int tid, int wave, int lane) {
    unsigned char* ws = P.ws;
    const bf16_t* Q = (const bf16_t*)(ws + WS_Q); const bf16_t* K = (const bf16_t*)(ws + WS_K); const bf16_t* Vt = (const bf16_t*)(ws + WS_VT); bf16_t* O = (bf16_t*)(ws + WS_CAT);
    for (int v = vcu; v < 256; v += G) {
        const int bh = v >> 2, j = v & 3;
        for (int i = 0; i < 4; ++i) { const int qb = (i == 0) ? 15 - 2 * j : (i == 1) ? 2 * j : (i == 2) ? 14 - 2 * j : 2 * j + 1;
            attn_unit(bh >> 3, bh & 7, qb, Q, K, Vt, (const float*)(ws + WS_CS), O, lds, tid, wave, lane); }
    }
}

#define XB_TMO      128
#define XB_XCNT(j)  (256  + 64 * (j))
#define XB_XSUB(j)  (1280 + 64 * (j))
#define XB_XGEN(j)  (2304 + 64 * (j))
#define XB_TOP      3328
#define XB_TOPGEN   3392
#define XCD_BAR_WORDS 3456
#define XB_SPIN_CAP (1u << 18)

__device__ __forceinline__ unsigned xb_ld(unsigned* p)              { return __hip_atomic_load(p, __ATOMIC_RELAXED, __HIP_MEMORY_SCOPE_AGENT); }
__device__ __forceinline__ unsigned xb_add(unsigned* p, unsigned v) { return __hip_atomic_fetch_add(p, v, __ATOMIC_RELAXED, __HIP_MEMORY_SCOPE_AGENT); }
__device__ __forceinline__ unsigned xb_xcc_id() { return (unsigned)__builtin_amdgcn_s_getreg((3 << 11) | 20) & 0xFu; }
#define XB_SPIN(cond, bar) do { unsigned _sp = 0; while (cond) { __builtin_amdgcn_s_sleep(1); \
    if ((++_sp & 255u) == 0u) { if (xb_ld(&(bar)[XB_TMO])) break; if (_sp > XB_SPIN_CAP) { atomicAdd(&(bar)[XB_TMO], 1u); break; } } } } while (0)

struct XcdBarrier {
    unsigned* bar; unsigned x;
    volatile LAS unsigned* st;
};

__device__ __forceinline__ XcdBarrier xcd_barrier_post(unsigned* bar, volatile LAS unsigned* st) {
    XcdBarrier b; b.bar = bar; b.x = xb_xcc_id(); b.st = st;
    if (threadIdx.x == 0) (void)xb_add(&bar[XB_XCNT(b.x)], 1u);
    return b;
}
__device__ __forceinline__ void xcd_barrier_complete(unsigned* bar, unsigned x, unsigned& nloc, unsigned& nx) {
    const unsigned G = gridDim.x * gridDim.y * gridDim.z;
    unsigned sum, cnt, mine, sp = 0u;
    for (;;) {
        sum = 0u; cnt = 0u; mine = 0u;
#pragma unroll
        for (unsigned j = 0; j < 16; ++j) { const unsigned c = xb_ld(&bar[XB_XCNT(j)]); sum += c; cnt += (c > 0u) ? 1u : 0u; mine = (j == x) ? c : mine; }
        if (sum == G) break;
        __builtin_amdgcn_s_sleep(1);
        if ((++sp & 255u) == 0u) { if (xb_ld(&bar[XB_TMO])) break; if (sp > XB_SPIN_CAP) { atomicAdd(&bar[XB_TMO], 1u); break; } }
    }
    nloc = mine > 0u ? mine : 1u; nx = cnt > 0u ? cnt : 1u;
}

__device__ __forceinline__ void xcd_barrier(const XcdBarrier& b) {
    asm volatile("s_waitcnt vmcnt(0)" ::: "memory");
    __syncthreads();
    if (threadIdx.x == 0) {
        unsigned* bar = b.bar;
        __builtin_amdgcn_s_waitcnt(0);
        unsigned nloc = b.st[0], nx = b.st[1];
        if (nloc == 0u) { xcd_barrier_complete(bar, b.x, nloc, nx); b.st[0] = nloc; b.st[1] = nx; }
        const unsigned old = xb_add(&bar[XB_XSUB(b.x)], 1u);
        const unsigned gen = old / nloc;
        if (old + 1u == (gen + 1u) * nloc) {
            __builtin_amdgcn_fence(__ATOMIC_RELEASE, "agent");
            asm volatile("s_waitcnt vmcnt(0)" ::: "memory");
            const unsigned og = xb_add(&bar[XB_TOP], 1u);
            const unsigned tg = og / nx;
            if (og + 1u == (tg + 1u) * nx) xb_add(&bar[XB_TOPGEN], 1u);
            else XB_SPIN(xb_ld(&bar[XB_TOPGEN]) == tg, bar);
            __builtin_amdgcn_fence(__ATOMIC_ACQUIRE, "agent");
            xb_add(&bar[XB_XGEN(b.x)], 1u);
            asm volatile("s_waitcnt vmcnt(0)" ::: "memory");
        } else {
            XB_SPIN(xb_ld(&bar[XB_XGEN(b.x)]) == gen, bar);
            __builtin_amdgcn_fence(__ATOMIC_ACQUIRE, "agent");
            asm volatile("s_waitcnt vmcnt(0)" ::: "memory");
        }
    }
    __syncthreads();
}

__global__ void __launch_bounds__(512) hymba_fwd(Params P) {
    extern __shared__ __attribute__((aligned(16))) unsigned char lds_raw[];
    LAS unsigned char* lds = (LAS unsigned char*)lds_raw;
    const int tid = threadIdx.x, lane = tid & 63, wave = __builtin_amdgcn_readfirstlane(tid >> 6);
    const int G = gridDim.x, bx = blockIdx.x;
    const int vcu = (G % 8 == 0) ? (bx % 8) * (G / 8) + bx / 8 : bx;
    unsigned char* ws = P.ws;
    bf16_t* XB = (bf16_t*)(ws + WS_XB);
    const int lo = P.ph_lo, hi = P.ph_hi;
    volatile LAS unsigned* bst = (volatile LAS unsigned*)(lds + 131072 + 512);
    if (tid < 2) bst[tid] = 0u;
    __syncthreads();
    XcdBarrier bar; bar.bar = (unsigned*)(ws + WS_BAR); bar.x = 0; bar.st = bst;
#ifndef PHASE_MASK
#define PHASE_MASK 0x1FF
#endif
#ifndef REP_MASK
#define REP_MASK 0x000
#endif
#define IN(k) ((((PHASE_MASK) >> (k)) & 1) && lo <= (k) && (k) < hi)
#define SEAM(k) do { if (IN(k) && IN((k) + 1)) { if ((k) == 0) cg::this_grid().sync(); else xcd_barrier(bar); } } while (0)
    if (IN(0)) { phase_prologue(P, lds, vcu, G, wave, lane);
        { u32x4* zc = (u32x4*)(ws + WS_CTL); const u32x4 z = {0u, 0u, 0u, 0u}; const int gtz = (vcu * 8 + wave) * 64 + lane;
          for (int i = gtz; i < (int)((CTL_BYTES + BAR_BYTES + FLAG_BYTES + ROWSS_BYTES) / 16); i += G * 512) zc[i] = z; }
        __syncthreads(); } SEAM(0);
    if (hi - lo > 1) bar = xcd_barrier_post((unsigned*)(ws + WS_BAR), bst);
    if (IN(1)) { { EpiProj E{(bf16_t*)(ws + WS_PROJ), (bf16_t*)(ws + WS_GLU)};
          run_gemm(lds, XB, (const bf16_t*)(ws + WS_WIN), TT, NPROJ_P, DM, G, bx, E); }
        { const bool hiw = bx >= G / 2; const size_t ro = hiw ? 0 : 24576;
          EpiPe E{(bf16_t*)(ws + WS_PE) + ro * DM, (float*)(ws + WS_ROWSS) + ro};
          run_gemm(lds, (const bf16_t*)(ws + WS_PBF) + ro * PLE, (const bf16_t*)(ws + WS_WPP), hiw ? 24576 : 8192, DM, PLE, G / 2, hiw ? bx - G / 2 : bx, E); }
    } SEAM(1);
    if (IN(2)) { phase_r1(P, lds, vcu, G, tid, wave, lane); } SEAM(2);
    if (IN(3)) {
#pragma nounroll
        for (int gi = 0; gi < 3; ++gi) {
            const bf16_t* A = (const bf16_t*)(ws + (gi == 0 ? WS_QAN : gi == 1 ? WS_KVAN : WS_WV));
            const bf16_t* Bt = (const bf16_t*)(ws + (gi == 0 ? WS_WQ : gi == 1 ? WS_WK : WS_KVAN));
            const int M = gi == 2 ? 512 : TT, N = gi == 0 ? NQ : gi == 1 ? 512 : TT, K = gi == 0 ? QL : KVL;
            EpiStore E{(bf16_t*)(ws + (gi == 0 ? WS_Q : gi == 1 ? WS_K : WS_VT)), gi == 2 ? (long)SEQ : (long)NQ, gi == 0 ? 30 : gi == 1 ? 6 : 12, gi == 1 ? 96L : gi == 2 ? 512L * SEQ : 0L};
            const bool upk = gi == 1; const bool hiw = bx >= G / 2;
            run_gemm(lds, A, Bt, (upk && !hiw) ? 0 : M, N, K, upk ? G / 2 : G, (upk && hiw) ? bx - G / 2 : bx, E);
        }
    } SEAM(3);
    if (IN(4)) { phase_attn(P, lds, vcu, G, tid, wave, lane); } SEAM(4);
    if (IN(5)) {
        PanelSumsq s1{(float*)(ws + WS_SLOT), (unsigned*)(ws + WS_CTL), 0, EPS}, s2{(float*)(ws + WS_SLOT + SLOT_BANK), (unsigned*)(ws + WS_CTL) + 128 * 64, 0, EPS};
        EpiWo E{P.x, (bf16_t*)(ws + WS_H1B), XB, P.g_mix_post, P.g_ffn_pre, s1, s2, lds + 131072 + 5120};
        run_gemm(lds, (const bf16_t*)(ws + WS_CAT), (const bf16_t*)(ws + WS_WO), TT, DM, DM, G, bx, E);
    } SEAM(5);
    if (IN(6)) { EpiGU E{(bf16_t*)(ws + WS_ACT), P.dw_w, P.dw_b, (float*)(ws + WS_HALO), (unsigned*)(ws + WS_FLAG), (PG8_LAS float*)(lds + 131072 + 1024)};
        run_gemm(lds, XB, (const bf16_t*)(ws + WS_WG), TT, 2 * DFF, DM, G, bx, E); } SEAM(6);
    if (IN(7)) {
        PanelSumsq s3{(float*)(ws + WS_SLOT + 2 * SLOT_BANK), (unsigned*)(ws + WS_CTL) + 2 * 128 * 64, 0, EPS};
        EpiDown E{(const bf16_t*)(ws + WS_H1B), XB, P.g_ffn_post, s3, lds + 131072 + 5120};
        run_gemm(lds, (const bf16_t*)(ws + WS_ACT), (const bf16_t*)(ws + WS_WD), TT, DM, DFF, G, bx, E);
    } SEAM(7);
    if (IN(8)) { EpiOut E{P.out, XB, (const bf16_t*)(ws + WS_PE), (const float*)(ws + WS_ROWSS), P.g_ple};
        run_gemm(lds, XB, (const bf16_t*)(ws + WS_WPG), TT, DM, DM, G, bx, E); }
#undef IN
#undef SEAM
}

#ifndef N_LAUNCHES
#define N_LAUNCHES 1
#endif
extern "C" void kernel_launch(void* const* d_in, const int* in_sizes, int n_in, void* d_out, int out_size, void* d_ws, size_t ws_size, hipStream_t stream) {
    static int grid = 0;
    if (grid == 0) {
        if (n_in != 25 || in_sizes[0] != TT * DM || out_size != TT * DM || ws_size < WS_END) {
            fprintf(stderr, "kernel_launch: unexpected problem: n_in %d in0 %d out %d ws %zu (need %zu)\n", n_in, n_in > 0 ? in_sizes[0] : -1, out_size, ws_size, (size_t)WS_END); grid = -1; return; }
        int dev = 0, cus = 0, per_cu = 0;
        hipGetDevice(&dev); hipDeviceGetAttribute(&cus, hipDeviceAttributeMultiprocessorCount, dev);
        if (hipFuncSetAttribute((const void*)hymba_fwd, hipFuncAttributeMaxDynamicSharedMemorySize, LDS_BYTES) != hipSuccess) { fprintf(stderr, "kernel_launch: hipFuncSetAttribute failed\n"); grid = -1; return; }
        if (hipOccupancyMaxActiveBlocksPerMultiprocessor(&per_cu, (const void*)hymba_fwd, 512, LDS_BYTES) != hipSuccess || per_cu < 1) { fprintf(stderr, "kernel_launch: occupancy query says %d\n", per_cu); per_cu = 1; }
        (void)hipGetLastError();
        grid = 256;
        if (cus != 256) fprintf(stderr, "kernel_launch: device has %d CUs, kernel is built for 256\n", cus);
    }
    if (grid < 0) return;
    Params a{};
    a.x = (const float*)d_in[0]; a.p = (const float*)d_in[1]; a.pos = (const int*)d_in[2];
    a.g_mix_pre = (const float*)d_in[3]; a.w_in = (const float*)d_in[4]; a.g_q_a = (const float*)d_in[5]; a.w_q_b = (const float*)d_in[6];
    a.g_kv_a = (const float*)d_in[7]; a.w_kv_b = (const float*)d_in[8]; a.conv_w = (const float*)d_in[9]; a.conv_b = (const float*)d_in[10];
    a.conv_ln_g = (const float*)d_in[11]; a.conv_ln_b = (const float*)d_in[12]; a.w_o = (const float*)d_in[13]; a.g_mix_post = (const float*)d_in[14];
    a.g_ffn_pre = (const float*)d_in[15]; a.w_gate = (const float*)d_in[16]; a.w_up = (const float*)d_in[17]; a.dw_w = (const float*)d_in[18];
    a.dw_b = (const float*)d_in[19]; a.w_down = (const float*)d_in[20]; a.g_ffn_post = (const float*)d_in[21]; a.w_ple_proj = (const float*)d_in[22];
    a.g_ple = (const float*)d_in[23]; a.w_ple_gate = (const float*)d_in[24];
    a.out = (float*)d_out; a.ws = (unsigned char*)d_ws;
#if N_LAUNCHES == 1
    a.ph_lo = 0; a.ph_hi = NPHASE;
    void* args[] = {&a};
    hipError_t e = hipLaunchCooperativeKernel((const void*)hymba_fwd, dim3(grid), dim3(512), args, LDS_BYTES, stream);
    if (e != hipSuccess) fprintf(stderr, "kernel_launch: cooperative launch failed: %s (grid %d)\n", hipGetErrorString(e), grid);
#else
    for (int ph = 0; ph < NPHASE; ++ph) for (int rep = 0; rep <= (((REP_MASK) >> ph) & 1); ++rep) {
        a.ph_lo = ph; a.ph_hi = ph + 1;
        hipLaunchKernelGGL(hymba_fwd, dim3(grid), dim3(512), LDS_BYTES, stream, a);
    }
#endif
}
```
